# Optimizing an MI355X kernel written in HIP

```python
import math
import jax, jax.numpy as jnp
from jax import lax
import numpy as np

D_MODEL = 2048
BATCH = 1
SEQ = 16384
DEPTH = 1

GRID_W = 64
WIN_H = 8
WIN_W = 16
Q_BLOCK = 128
HEAD_DIM = 128
NA_WIDTH = D_MODEL // 2
NA_HEADS = NA_WIDTH // HEAD_DIM
SSM_WIDTH = D_MODEL // 4
SSM_CH = 16
SSM_GROUPS = SSM_WIDTH // SSM_CH
SSM_STATE = 64
MEM_WIDTH = D_MODEL // 4
MEM_HEADS = 4
MEM_HEAD_DIM = MEM_WIDTH // MEM_HEADS
N_MEM = 256
MIX_WIDTH = NA_WIDTH + SSM_WIDTH + MEM_WIDTH
IN_WIDTH = 3 * NA_WIDTH + SSM_WIDTH + MEM_WIDTH
D_FF = 4 * D_MODEL
EPS = 1e-6
DT_MIN = 1e-3
DT_MAX = 1e-1
LAM_RE_MAX = -1e-4

kernel_name = "hybrid_natten_s5_memory_block"


def rmsnorm(x, g):
    xf = x.astype(jnp.float32)
    y = xf * lax.rsqrt(jnp.mean(xf * xf, axis=-1, keepdims=True) + EPS)
    return (y * g.astype(jnp.float32)).astype(x.dtype)


def neighbourhood_tables(S):
    rows = S // GRID_W
    kh = min(WIN_H, rows)
    kw = min(WIN_W, GRID_W)
    t = jnp.arange(S, dtype=jnp.int32)
    r = t // GRID_W
    c = t % GRID_W
    rs = jnp.clip(r - kh // 2, 0, rows - kh)
    cs = jnp.clip(c - kw // 2, 0, GRID_W - kw)
    kr = rs[:, None, None] + jnp.arange(kh, dtype=jnp.int32)[None, :, None]
    kc = cs[:, None, None] + jnp.arange(kw, dtype=jnp.int32)[None, None, :]
    nbr = (kr * GRID_W + kc).reshape(S, kh * kw)
    off = ((kr - r[:, None, None] + WIN_H - 1) * (2 * WIN_W - 1)
           + (kc - c[:, None, None] + WIN_W - 1)).reshape(S, kh * kw)
    return nbr, off


def neighbourhood_attention(q, k, v, rpb):
    B, S, H, Dh = q.shape
    nbr, off = neighbourhood_tables(S)
    nk = nbr.shape[1]
    nb = S // Q_BLOCK
    rpb_flat = rpb.reshape(H, -1).astype(jnp.float32)
    scale = Dh ** -0.5
    qb = q.reshape(B, nb, Q_BLOCK, H, Dh).transpose(1, 0, 2, 3, 4)

    def block(args):
        q_blk, idx, bidx = args
        k_g = k[:, idx]
        v_g = v[:, idx]
        s = jnp.einsum('bqhd,bqkhd->bhqk', q_blk, k_g,
                       preferred_element_type=jnp.float32) * scale + rpb_flat[:, bidx][None]
        p = jax.nn.softmax(s, axis=-1).astype(v.dtype)
        return jnp.einsum('bhqk,bqkhd->bqhd', p, v_g)

    out = lax.map(block, (qb, nbr.reshape(nb, Q_BLOCK, nk), off.reshape(nb, Q_BLOCK, nk)))
    return out.transpose(1, 0, 2, 3, 4).reshape(B, S, H * Dh)


def s5_direction(u, lam_re, lam_im, log_dt, b_re, b_im, c_re, c_im, reverse):
    lam = lax.complex(jnp.minimum(lam_re.astype(jnp.float32), LAM_RE_MAX),
                      lam_im.astype(jnp.float32))
    dt = jnp.exp(log_dt.astype(jnp.float32))[:, None]
    lam_bar = jnp.exp(lam * dt)
    b = lax.complex(b_re.astype(jnp.float32), b_im.astype(jnp.float32))
    b_bar = ((lam_bar - 1.0) / lam)[..., None] * b
    bu = jnp.einsum('bsgc,gpc->bsgp', u.astype(jnp.complex64), b_bar)
    a = jnp.broadcast_to(lam_bar, bu.shape)

    def combine(e1, e2):
        a1, x1 = e1
        a2, x2 = e2
        return a1 * a2, a2 * x1 + x2

    _, h = lax.associative_scan(combine, (a, bu), axis=1, reverse=reverse)
    c = lax.complex(c_re.astype(jnp.float32), c_im.astype(jnp.float32))
    return jnp.einsum('bsgp,gcp->bsgc', h, c).real


def s5_mixer(u_flat, lam_re, lam_im, log_dt, b_re, b_im, c_re, c_im, d, w_glu, b_glu):
    B, S, _ = u_flat.shape
    u = u_flat.reshape(B, S, SSM_GROUPS, SSM_CH).astype(jnp.float32)
    y_f = s5_direction(u, lam_re[0], lam_im[0], log_dt[0], b_re[0], b_im[0], c_re[0], c_im[0], False)
    y_b = s5_direction(u, lam_re[1], lam_im[1], log_dt[1], b_re[1], b_im[1], c_re[1], c_im[1], True)
    y = (y_f + y_b + d.astype(jnp.float32) * u).reshape(B, S, SSM_WIDTH)
    y = jax.nn.gelu(y)
    y = y * jax.nn.sigmoid(y @ w_glu.astype(jnp.float32) + b_glu.astype(jnp.float32))
    return y.astype(u_flat.dtype)


def memory_cross_attention(q_flat, mem, mem_norm, w_mem_kv):
    B, S, _ = q_flat.shape
    q = q_flat.reshape(B, S, MEM_HEADS, MEM_HEAD_DIM)
    kv = rmsnorm(mem, mem_norm) @ w_mem_kv
    M = kv.shape[1]
    k, v = jnp.split(kv, 2, axis=-1)
    k = k.reshape(B, M, MEM_HEADS, MEM_HEAD_DIM)
    v = v.reshape(B, M, MEM_HEADS, MEM_HEAD_DIM)
    s = jnp.einsum('bshd,bmhd->bhsm', q, k, preferred_element_type=jnp.float32) * MEM_HEAD_DIM ** -0.5
    p = jax.nn.softmax(s, axis=-1).astype(v.dtype)
    return jnp.einsum('bhsm,bmhd->bshd', p, v).reshape(B, S, MEM_WIDTH)


def setup_inputs(seed: int = 0) -> dict:
    key = jax.random.key(seed)
    ks = jax.random.split(key, 32)
    L = DEPTH
    f32 = jnp.float32

    def dense(k, shape, fan_in):
        return jax.random.normal(k, shape, f32) * fan_in ** -0.5

    def gain(k, shape):
        return 1.0 + 0.02 * jax.random.normal(k, shape, f32)

    n = jnp.arange(SSM_STATE, dtype=f32)
    G, P, Cg = SSM_GROUPS, SSM_STATE, SSM_CH
    return {
        "x": jax.random.normal(ks[0], (BATCH, SEQ, D_MODEL), f32),
        "mem": jax.random.normal(ks[1], (BATCH, N_MEM, D_MODEL), f32),
        "norm_mix_pre": gain(ks[2], (L, D_MODEL)),
        "w_in": dense(ks[3], (L, D_MODEL, IN_WIDTH), D_MODEL),
        "na_rpb": 0.02 * jax.random.normal(ks[4], (L, NA_HEADS, 2 * WIN_H - 1, 2 * WIN_W - 1), f32),
        "ssm_lam_re": -0.5 + 0.01 * jax.random.normal(ks[5], (L, 2, G, P), f32),
        "ssm_lam_im": math.pi * n + 0.01 * jax.random.normal(ks[6], (L, 2, G, P), f32),
        "ssm_log_dt": jax.random.uniform(ks[7], (L, 2, G), f32, math.log(DT_MIN), math.log(DT_MAX)),
        "ssm_b_re": dense(ks[8], (L, 2, G, P, Cg), 2 * Cg),
        "ssm_b_im": dense(ks[9], (L, 2, G, P, Cg), 2 * Cg),
        "ssm_c_re": dense(ks[10], (L, 2, G, Cg, P), 2 * P),
        "ssm_c_im": dense(ks[11], (L, 2, G, Cg, P), 2 * P),
        "ssm_d": jax.random.normal(ks[12], (L, G, Cg), f32),
        "w_glu": dense(ks[13], (L, SSM_WIDTH, SSM_WIDTH), SSM_WIDTH),
        "b_glu": 0.01 * jax.random.normal(ks[14], (L, SSM_WIDTH), f32),
        "mem_norm": gain(ks[15], (L, D_MODEL)),
        "w_mem_kv": dense(ks[16], (L, D_MODEL, 2 * MEM_WIDTH), D_MODEL),
        "out_norm_na": gain(ks[17], (L, NA_WIDTH)),
        "out_norm_ssm": gain(ks[18], (L, SSM_WIDTH)),
        "out_norm_mem": gain(ks[19], (L, MEM_WIDTH)),
        "w_out": dense(ks[20], (L, MIX_WIDTH, D_MODEL), MIX_WIDTH),
        "norm_mix_post": gain(ks[21], (L, D_MODEL)),
        "norm_mlp_pre": gain(ks[22], (L, D_MODEL)),
        "w_ff1": dense(ks[23], (L, D_MODEL, D_FF), D_MODEL),
        "w_ff2": dense(ks[24], (L, D_FF, D_MODEL), D_FF),
        "norm_mlp_post": gain(ks[25], (L, D_MODEL)),
    }


def reference(x, mem, norm_mix_pre, w_in, na_rpb, ssm_lam_re, ssm_lam_im, ssm_log_dt,
              ssm_b_re, ssm_b_im, ssm_c_re, ssm_c_im, ssm_d, w_glu, b_glu, mem_norm,
              w_mem_kv, out_norm_na, out_norm_ssm, out_norm_mem, w_out, norm_mix_post,
              norm_mlp_pre, w_ff1, w_ff2, norm_mlp_post):
    B, S, _ = x.shape
    for l in range(DEPTH):
        h = rmsnorm(x, norm_mix_pre[l])
        proj = h @ w_in[l]
        q_na, k_na, v_na, u_ssm, q_mem = jnp.split(
            proj, [NA_WIDTH, 2 * NA_WIDTH, 3 * NA_WIDTH, 3 * NA_WIDTH + SSM_WIDTH], axis=-1)
        hs = (B, S, NA_HEADS, HEAD_DIM)
        y_na = neighbourhood_attention(q_na.reshape(hs), k_na.reshape(hs), v_na.reshape(hs), na_rpb[l])
        y_ssm = s5_mixer(u_ssm, ssm_lam_re[l], ssm_lam_im[l], ssm_log_dt[l], ssm_b_re[l], ssm_b_im[l],
                         ssm_c_re[l], ssm_c_im[l], ssm_d[l], w_glu[l], b_glu[l])
        y_mem = memory_cross_attention(q_mem, mem, mem_norm[l], w_mem_kv[l])
        y = jnp.concatenate([rmsnorm(y_na, out_norm_na[l]),
                             rmsnorm(y_ssm, out_norm_ssm[l]),
                             rmsnorm(y_mem, out_norm_mem[l])], axis=-1)
        x = x + rmsnorm(y @ w_out[l], norm_mix_post[l])
        h = rmsnorm(x, norm_mlp_pre[l])
        f = jnp.square(jax.nn.relu(h @ w_ff1[l])) @ w_ff2[l]
        x = x + rmsnorm(f, norm_mlp_post[l])
    return x
```

```cpp
#include <hip/hip_runtime.h>
#include <cstdio>
#include <cstdint>
#ifndef PROBE_NA_REP
#define PROBE_NA_REP 1
#endif
#ifndef PROBE_MEM_REP
#define PROBE_MEM_REP 1
#endif
#ifndef PROBE_SCAN_REP
#define PROBE_SCAN_REP 1
#endif
#ifndef STAGGER_US
#define STAGGER_US 0
#endif
#ifndef PROBE_XBAR
#define PROBE_XBAR 0
#endif

namespace pg8 {
#define PG8_LAS __attribute__((address_space(3)))
typedef unsigned short bf16_t;
typedef short bf16x8 __attribute__((ext_vector_type(8)));
typedef float f32x4 __attribute__((ext_vector_type(4)));
typedef unsigned u32x4 __attribute__((ext_vector_type(4)));
constexpr int BM = 256, BK = 64, HALF = 128, HTB = HALF * BK * 2  , STAGE_BYTES = 8 * HTB, NXCD = 8, WGM = 8;

__host__ __device__ __forceinline__ int lds_byte(int r, int c) { const int st = (r >> 4) * 2 + (c >> 5), rr = r & 15, cc = c & 31, ob = rr * 64 + cc * 2; return st * 1024 + (ob ^ (((ob >> 9) & 1) << 5)); }
__host__ __device__ __forceinline__ void stage_rc(int b, int& R, int& C) { const int st = b / 1024, sb = b % 1024, swz = sb ^ (((sb >> 9) & 1) << 5); R = (st >> 1) * 16 + swz / 64; C = (st & 1) * 32 + (swz % 64) / 2; }
__host__ __device__ __forceinline__ int perm32(int rho) { const int n = rho >> 4, i = rho & 15; return 8 * (i >> 2) + 4 * n + (i & 3); }

struct Unit { int pm, pn, om, on; };
struct Gemm { const bf16_t* A; const bf16_t* Bt; int K, lda, ldb; };

struct StaticOrder {
    int nM, nN, nwg, G, c;
    __host__ __device__ void init(int M, int N, int G_, int c_) { nM = M / BM; nN = N / BM; nwg = nM * nN; G = G_; c = c_; }
    __host__ __device__ bool next(int i, Unit& u) const {
        const long L = (long)i * G + c; if (L >= nwg) return false;
        int wgid = (int)L; { const int q = nwg / NXCD, r = nwg % NXCD, xcd = wgid % NXCD, off = wgid / NXCD; wgid = (xcd < r ? xcd * (q + 1) : r * (q + 1) + (xcd - r) * q) + off; }
        const int nig = WGM * nN, gid = wgid / nig, fm = gid * WGM, gsz = (nM - fm) < WGM ? (nM - fm) : WGM;
        u.pm = fm + ((wgid % nig) % gsz); u.pn = (wgid % nig) / gsz; u.om = u.pm; u.on = u.pn; return true;
    }
    __device__ __forceinline__ void a_ready(const Unit&) const {}
    __device__ __forceinline__ void done(const Unit&) const {}
};
struct BatchOrder {
    int nb, njb, G, c;
    __host__ __device__ void init(int nb_, int njb_, int G_, int c_) { nb = nb_; njb = njb_; G = G_; c = c_; }
    __host__ __device__ bool next(int i, Unit& u) const {
        const long L = (long)i * G + c; if (L >= (long)nb * njb) return false;
        const int b = (int)L / njb, j = (int)L % njb; u.pm = b; u.pn = b * njb + j; u.om = b; u.on = j; return true;
    }
    __device__ __forceinline__ void a_ready(const Unit&) const {}
    __device__ __forceinline__ void done(const Unit&) const {}
};

struct PanelOrder {
    int nM, nN, nwg, G, c;
    __host__ __device__ void init(int M, int N, int G_, int c_) { nM = M / BM; nN = N / BM; nwg = nM * nN; G = G_; c = c_; }
    __host__ __device__ bool next(int i, Unit& u) const {
        const long L = (long)i * G + c; if (L >= nwg) return false;
        int wgid = (int)L; { const int q = nwg / NXCD, r = nwg % NXCD, xcd = wgid % NXCD, off = wgid / NXCD; wgid = (xcd < r ? xcd * (q + 1) : r * (q + 1) + (xcd - r) * q) + off; }
        const int nig = WGM * nN, gid = wgid / nig, fm = gid * WGM, w = wgid % nig;
        u.pm = fm + w / nN; u.pn = w % nN; u.om = u.pm; u.on = u.pn; return true;
    }
    __device__ __forceinline__ void a_ready(const Unit&) const {}
    __device__ __forceinline__ void done(const Unit&) const {}
};
struct TwoUnits { Unit u0, u1; __host__ __device__ bool next(int i, Unit& o) const { if (i > 1) return false; o = i ? u1 : u0; return true; }
    __device__ __forceinline__ void a_ready(const Unit&) const {} __device__ __forceinline__ void done(const Unit&) const {} };
struct GroupFf1Order { int pa, mem, first, count; __host__ __device__ bool next(int i, Unit& o) const { if (i >= count) return false; const int k = first + i; o.pm = pa + (k >> 2); o.pn = 8 * (k & 3) + mem; o.om = o.pm; o.on = o.pn; return true; }
    __device__ __forceinline__ void a_ready(const Unit&) const {} __device__ __forceinline__ void done(const Unit&) const {} };
struct OneUnit { Unit u; __host__ __device__ bool next(int i, Unit& o) const { if (i) return false; o = u; return true; }
    __device__ __forceinline__ void a_ready(const Unit&) const {} __device__ __forceinline__ void done(const Unit&) const {} };
__device__ __forceinline__ unsigned cvt_pk_bf16(float lo, float hi) { unsigned r; asm volatile("v_cvt_pk_bf16_f32 %0, %1, %2" : "=v"(r) : "v"(lo), "v"(hi)); return r; }
__device__ __forceinline__ u32x4 pack8(const f32x4 v0, const f32x4 v1) { u32x4 w; w.x = cvt_pk_bf16(v0[0], v0[1]); w.y = cvt_pk_bf16(v0[2], v0[3]); w.z = cvt_pk_bf16(v1[0], v1[1]); w.w = cvt_pk_bf16(v1[2], v1[3]); return w; }
__device__ __forceinline__ float bf2f(unsigned short b) { return __uint_as_float(((unsigned)b) << 16); }

__device__ __forceinline__ void store16_wt(void* p, u32x4 v) { asm volatile("global_store_dwordx4 %0, %1, off sc1\n\ts_nop 1" :: "v"(p), "v"(v) : "memory"); }
struct EpiInProj {
    static constexpr bool PERM = true, AFTER_DRAIN = false, KSCALE = false;
    unsigned char* ws; size_t off_qkv, off_u, off_qm;
    __device__ __forceinline__ void operator()(const f32x4 (&acc)[2][2][4][2], const Unit& u, int wr, int wc, int fr, int fq) const {
        const int ct = u.on, row0 = u.om * BM + wr * 64 + fr, cin = wc * 32 + 8 * fq;
#pragma unroll
        for (int ai = 0; ai < 2; ++ai)
#pragma unroll
            for (int m = 0; m < 4; ++m) { const int row = row0 + ai * HALF + m * 16;
#pragma unroll
                for (int bj = 0; bj < 2; ++bj) { const int c = cin + bj * HALF; const u32x4 w = pack8(acc[ai][bj][m][0], acc[ai][bj][m][1]); size_t off;
                    if (ct < 12) off = off_qkv + (size_t)(ct >> 2) * (32u << 20) + ((size_t)row * 1024 + (ct & 3) * 256 + c) * 2;
                    else if (ct < 14) { const int ch = (ct - 12) * 256 + c; off = off_u + ((size_t)((ch >> 4) * 256 + (row >> 6)) * 1280 + (row & 63) * 16 + (ch & 15)) * 2; }
                    else off = off_qm + ((size_t)row * 512 + (ct - 14) * 256 + c) * 2;
                    *(u32x4*)(ws + off) = w; } }
    }
};
struct EpiF32 {
    static constexpr bool PERM = false, AFTER_DRAIN = false, KSCALE = false;
    float* C; int ldc;
    __device__ __forceinline__ void operator()(const f32x4 (&acc)[2][2][4][2], const Unit& u, int wr, int wc, int fr, int fq) const {
        const int row0 = u.om * BM + wr * 64 + fr, col0 = u.on * BM + wc * 32 + 4 * fq;
#pragma unroll
        for (int ai = 0; ai < 2; ++ai)
#pragma unroll
            for (int m = 0; m < 4; ++m) { float* rowp = C + (size_t)(row0 + ai * HALF + m * 16) * ldc + col0;
#pragma unroll
                for (int bj = 0; bj < 2; ++bj)
#pragma unroll
                    for (int n = 0; n < 2; ++n) *(f32x4*)(rowp + bj * HALF + n * 16) = acc[ai][bj][m][n]; }
    }
};
template <int ACT  > struct EpiBf16 {
    static constexpr bool PERM = true, AFTER_DRAIN = false, KSCALE = false;
    bf16_t* O; int ldc;
    __device__ __forceinline__ void operator()(const f32x4 (&acc)[2][2][4][2], const Unit& u, int wr, int wc, int fr, int fq) const {
        const int row0 = u.om * BM + wr * 64 + fr, col0 = u.on * BM + wc * 32 + 8 * fq;
#pragma unroll
        for (int ai = 0; ai < 2; ++ai)
#pragma unroll
            for (int m = 0; m < 4; ++m) { bf16_t* rowp = O + (size_t)(row0 + ai * HALF + m * 16) * ldc + col0;
#pragma unroll
                for (int bj = 0; bj < 2; ++bj) { f32x4 v0 = acc[ai][bj][m][0], v1 = acc[ai][bj][m][1];
                    if (ACT == 1) {
#pragma unroll
                        for (int j = 0; j < 4; ++j) { const float a = fmaxf(v0[j], 0.f), b = fmaxf(v1[j], 0.f); v0[j] = a * a; v1[j] = b * b; } }
                    if (ACT == 1) store16_wt(rowp + bj * HALF, pack8(v0, v1)); else *(u32x4*)(rowp + bj * HALF) = pack8(v0, v1); } }
    }
};
struct EpiFusedFinal {
    static constexpr bool PERM = false, AFTER_DRAIN = true, KSCALE = false;
    const float* x; const bf16_t* o; const float* rs1; const float* g1; const float* g2; float* out;
    unsigned* xs;
    unsigned* cnt;
    __device__ __forceinline__ void fused(f32x4 (&acc)[2][2][4][2], const Unit& u, int wr, int wc, int fr, int fq, PG8_LAS unsigned char* lds, int wid, int lane) const {
        PG8_LAS float* P = (PG8_LAS float*)(lds + 131072);
        PG8_LAS float* S = (PG8_LAS float*)(lds + 131072 + 4096);
#pragma unroll
        for (int ai = 0; ai < 2; ++ai)
#pragma unroll
            for (int m = 0; m < 4; ++m) { float s = 0.f;
#pragma unroll
                for (int bj = 0; bj < 2; ++bj)
#pragma unroll
                    for (int n = 0; n < 2; ++n) { const f32x4 v = acc[ai][bj][m][n]; s += (v[0] * v[0] + v[1] * v[1]) + (v[2] * v[2] + v[3] * v[3]); }
                s += __shfl_xor(s, 16); s += __shfl_xor(s, 32);
                if (fq == 0) P[(ai * HALF + wr * 64 + m * 16 + fr) * 4 + wc] = s; }
#pragma unroll
        for (int ai = 0; ai < 2; ++ai)
#pragma unroll
            for (int m = 0; m < 4; ++m) { const int r = ai * HALF + wr * 64 + m * 16 + fr;
#pragma unroll
                for (int bj = 0; bj < 2; ++bj)
#pragma unroll
                    for (int n = 0; n < 2; ++n) { const int ch = (bj * HALF + wc * 32 + n * 16 + 4 * fq) >> 2; const f32x4 v = acc[ai][bj][m][n];
                        *(PG8_LAS unsigned long long*)(lds + r * 512 + ((ch ^ (r & 15)) << 3)) = (unsigned long long)cvt_pk_bf16(v[0], v[1]) | ((unsigned long long)cvt_pk_bf16(v[2], v[3]) << 32); } }
        asm volatile("s_waitcnt lgkmcnt(0)" ::: "memory"); __builtin_amdgcn_s_barrier(); asm volatile("" ::: "memory");
        const int row = wid * 32 + (lane & 31);
        if (lane < 32) { const PG8_LAS f32x4* pp = (const PG8_LAS f32x4*)(P + row * 4); const f32x4 p = pp[0]; const float t = (p[0] + p[1]) + (p[2] + p[3]);
            __hip_atomic_store(xs + ((size_t)(u.pm * BM + row) * 8 + u.pn), __float_as_uint(t), __ATOMIC_RELAXED, __HIP_MEMORY_SCOPE_AGENT); }
        asm volatile("s_waitcnt vmcnt(0)" ::: "memory");
        if (lane == 0) __hip_atomic_fetch_add(cnt + 64 * u.pm, 1u, __ATOMIC_RELAXED, __HIP_MEMORY_SCOPE_AGENT);
        if (wid == 0) { unsigned sp = 0;
            while ((unsigned)__builtin_amdgcn_readfirstlane(__hip_atomic_load(cnt + 64 * u.pm, __ATOMIC_RELAXED, __HIP_MEMORY_SCOPE_AGENT)) < 64u) { __builtin_amdgcn_s_sleep(2); if (++sp > (1u << 22)) break; }
            __builtin_amdgcn_fence(__ATOMIC_ACQUIRE, "agent"); }
        asm volatile("s_waitcnt vmcnt(0) lgkmcnt(0)" ::: "memory"); __builtin_amdgcn_s_barrier(); asm volatile("" ::: "memory");
        if (lane < 32) { const unsigned* slot = xs + (size_t)(u.pm * BM + row) * 8; float tot = 0.f;
#pragma unroll
            for (int t = 0; t < 8; ++t) tot += __uint_as_float(__hip_atomic_load(slot + t, __ATOMIC_RELAXED, __HIP_MEMORY_SCOPE_AGENT));
            S[row] = 1.0f / sqrtf(tot * (1.0f / 2048.0f) + 1e-6f); }
        asm volatile("s_waitcnt lgkmcnt(0)" ::: "memory"); __builtin_amdgcn_s_barrier(); asm volatile("" ::: "memory");
        const size_t colg = (size_t)u.pn * BM + 4 * lane;
        const f32x4 ga = *(const f32x4*)(g1 + colg), gb = *(const f32x4*)(g2 + colg);
#pragma unroll 8
        for (int i = 0; i < 32; ++i) { const int r = wid * 32 + i; const size_t off = (size_t)(u.pm * BM + r) * 2048 + colg;
            const f32x4 xv = *(const f32x4*)(x + off); const unsigned long long ow = *(const unsigned long long*)(o + off);
            const unsigned long long fw = *(const PG8_LAS unsigned long long*)(lds + r * 512 + ((lane ^ (r & 15)) << 3));
            const float rsf = S[r], r1 = rs1[(size_t)(u.pm * BM + r)];
            const f32x4 ov = (f32x4){__uint_as_float((unsigned)ow << 16), __uint_as_float((unsigned)ow & 0xffff0000u), __uint_as_float((unsigned)(ow >> 32) << 16), __uint_as_float((unsigned)(ow >> 32) & 0xffff0000u)};
            const f32x4 fv = (f32x4){__uint_as_float((unsigned)fw << 16), __uint_as_float((unsigned)fw & 0xffff0000u), __uint_as_float((unsigned)(fw >> 32) << 16), __uint_as_float((unsigned)(fw >> 32) & 0xffff0000u)};
            *(f32x4*)(out + off) = xv + ov * r1 * ga + fv * rsf * gb; }
        asm volatile("s_waitcnt lgkmcnt(0)" ::: "memory"); __builtin_amdgcn_s_barrier(); asm volatile("" ::: "memory");
    }
};
struct EpiOutProj {
    static constexpr bool PERM = true, AFTER_DRAIN = false, KSCALE = true;
    bf16_t* O; int ldc; const float* rt;
    __device__ __forceinline__ void operator()(const f32x4 (&acc)[2][2][4][2], const Unit& u, int wr, int wc, int fr, int fq) const {
        const int row0 = u.om * BM + wr * 64 + fr, col0 = u.on * BM + wc * 32 + 8 * fq;
#pragma unroll
        for (int ai = 0; ai < 2; ++ai)
#pragma unroll
            for (int m = 0; m < 4; ++m) { bf16_t* rowp = O + (size_t)(row0 + ai * HALF + m * 16) * ldc + col0;
#pragma unroll
                for (int bj = 0; bj < 2; ++bj) store16_wt(rowp + bj * HALF, pack8(acc[ai][bj][m][0], acc[ai][bj][m][1])); }
    }
};
__device__ __forceinline__ float gelu_tanh(float x) {
    const float z = 0.7978845608028654f * (x + 0.044715f * x * x * x);
    return x * __builtin_amdgcn_rcpf(1.0f + __builtin_amdgcn_exp2f(-2.0f * 1.4426950408889634f * z));
}
struct EpiSsmD {
    static constexpr bool PERM = true, AFTER_DRAIN = false, KSCALE = false;
    bf16_t* Yg;
    __device__ __forceinline__ void operator()(const f32x4 (&acc)[2][2][4][2], const Unit& u, int wr, int wc, int fr, int fq) const {
        const int g = u.om, n0 = wr * 64 + fr, col0 = u.on * BM + wc * 32 + 8 * fq;
#pragma unroll
        for (int ai = 0; ai < 2; ++ai)
#pragma unroll
            for (int m = 0; m < 4; ++m) { const int n = n0 + ai * HALF + m * 16;
#pragma unroll
                for (int bj = 0; bj < 2; ++bj) { const int col = col0 + bj * HALF, t = col >> 4, c = col & 15; f32x4 v0 = acc[ai][bj][m][0], v1 = acc[ai][bj][m][1];
#pragma unroll
                    for (int j = 0; j < 4; ++j) { v0[j] = gelu_tanh(v0[j]); v1[j] = gelu_tanh(v1[j]); }
                    *(u32x4*)(Yg + (size_t)(n * 64 + t) * 512 + g * 16 + c) = pack8(v0, v1); } }
    }
};
struct EpiGlu {
    static constexpr bool PERM = true, AFTER_DRAIN = false, KSCALE = false;
    const bf16_t* Yg; const float* bglu; bf16_t* Y;
    __device__ __forceinline__ void operator()(const f32x4 (&acc)[2][2][4][2], const Unit& u, int wr, int wc, int fr, int fq) const {
        const int row0 = u.om * BM + wr * 64 + fr, col0 = u.on * BM + wc * 32 + 8 * fq;
#pragma unroll
        for (int ai = 0; ai < 2; ++ai)
#pragma unroll
            for (int m = 0; m < 4; ++m) { const int row = row0 + ai * HALF + m * 16;
#pragma unroll
                for (int bj = 0; bj < 2; ++bj) { const int col = col0 + bj * HALF;
                    const u32x4 yv = *(const u32x4*)(Yg + (size_t)row * 512 + col);
                    const f32x4 b0 = *(const f32x4*)(bglu + col), b1 = *(const f32x4*)(bglu + col + 4);
                    f32x4 v0 = acc[ai][bj][m][0] + b0, v1 = acc[ai][bj][m][1] + b1;
                    float y[8]; y[0] = __uint_as_float(yv.x << 16); y[1] = __uint_as_float(yv.x & 0xffff0000u); y[2] = __uint_as_float(yv.y << 16); y[3] = __uint_as_float(yv.y & 0xffff0000u);
                    y[4] = __uint_as_float(yv.z << 16); y[5] = __uint_as_float(yv.z & 0xffff0000u); y[6] = __uint_as_float(yv.w << 16); y[7] = __uint_as_float(yv.w & 0xffff0000u);
#pragma unroll
                    for (int j = 0; j < 4; ++j) { v0[j] = y[j] * __builtin_amdgcn_rcpf(1.0f + __builtin_amdgcn_exp2f(-1.4426950408889634f * v0[j]));
                                                  v1[j] = y[4 + j] * __builtin_amdgcn_rcpf(1.0f + __builtin_amdgcn_exp2f(-1.4426950408889634f * v1[j])); }
                    *(u32x4*)(Y + (size_t)row * 2048 + 1024 + col) = pack8(v0, v1); } }
    }
};

template <class Epi, class Sched, bool ALIGN_EPI = false, bool SP2 = false>
__device__ __forceinline__ void gemm_phase(PG8_LAS unsigned char* lds, const Gemm g, const Sched& S, const Epi& E) {
    int tid_ = threadIdx.x; asm volatile("" : "+v"(tid_));
    const int tid = tid_, wid = __builtin_amdgcn_readfirstlane(tid >> 6), lane = tid & 63, wr = wid >> 2, wc = wid & 3, fr = lane & 15, fq = lane >> 4;
    const int K = g.K, nt = K / BK;
    unsigned voffA[2], voffB[2];
#pragma unroll
    for (int i = 0; i < 2; ++i) { int R, C; stage_rc(tid * 16 + i * 8192, R, C); const int Rb = Epi::PERM ? ((R & ~31) + perm32(R & 31)) : R;
        voffA[i] = (unsigned)(R * g.lda + C) * 2u; voffB[i] = (unsigned)(Rb * g.ldb + C) * 2u; }
    const size_t kstep = (size_t)(BK * 2);
    const size_t hstepA = (size_t)HALF * g.lda * 2, hstepB = (size_t)HALF * g.ldb * 2;
    const size_t tstepA = 2 * hstepA, tstepB = 2 * hstepB;
    const unsigned ldsw = (unsigned)wid * 1024u;
    const int aoff = lds_byte(wr * 64 + fr, fq * 8), boff = lds_byte(wc * 32 + fr, fq * 8);
#define PG8_SA(b, h) (((b) * 2 + (h)) * HTB)
#define PG8_SB(b, h) ((4 + (b) * 2 + (h)) * HTB)
#define PG8_STAGE(bufoff, gbase, voff) do { _Pragma("unroll") for (int _i = 0; _i < 2; ++_i) \
        __builtin_amdgcn_global_load_lds((const unsigned*)((const char*)(gbase) + (voff)[_i]), (PG8_LAS unsigned*)(lds + (bufoff) + ldsw + _i * 8192), 16, 0, 0); } while (0)
#define PG8_LDA(dst, b, h) do { _Pragma("unroll") for (int m = 0; m < 4; ++m) _Pragma("unroll") for (int k = 0; k < 2; ++k) dst[m][k] = *(const PG8_LAS bf16x8*)(lds + PG8_SA(b, h) + aoff + m * 2048 + k * 1024); } while (0)
#define PG8_LDB(dst, b, h) do { _Pragma("unroll") for (int n = 0; n < 2; ++n) _Pragma("unroll") for (int k = 0; k < 2; ++k) dst[n][k] = *(const PG8_LAS bf16x8*)(lds + PG8_SB(b, h) + boff + n * 2048 + k * 1024); } while (0)
#define PG8_MMA(ai, bj, At, Bt) do { __builtin_amdgcn_s_setprio(1); _Pragma("unroll") for (int m = 0; m < 4; ++m) _Pragma("unroll") for (int n = 0; n < 2; ++n) _Pragma("unroll") for (int k = 0; k < 2; ++k) \
        acc[ai][bj][m][n] = __builtin_amdgcn_mfma_f32_16x16x32_bf16(Bt[n][k], At[m][k], acc[ai][bj][m][n], 0, 0, 0); __builtin_amdgcn_s_setprio(0); } while (0)
#define PG8_WAIT_V(n) asm volatile("s_waitcnt vmcnt(" #n ")" ::: "memory")
#define PG8_WAIT_L(n) asm volatile("s_waitcnt lgkmcnt(" #n ")" ::: "memory")
#define PG8_BAR __builtin_amdgcn_s_barrier()
#define PG8_SCHED __builtin_amdgcn_sched_barrier(0)
    Unit cur, nxt; int ui = 0;
    if (!S.next(0, cur)) return;
    if constexpr (Epi::KSCALE) {
        PG8_LAS float* xt = (PG8_LAS float*)(lds + STAGE_BYTES);
        xt[tid] = E.rt[(size_t)cur.pm * 512 + tid];
        Unit u1; if (S.next(1, u1)) xt[512 + tid] = E.rt[(size_t)u1.pm * 512 + tid];
    }
    f32x4 acc[2][2][4][2];
#pragma unroll
    for (int a = 0; a < 2; ++a)
#pragma unroll
        for (int b = 0; b < 2; ++b)
#pragma unroll
            for (int m = 0; m < 4; ++m)
#pragma unroll
                for (int n = 0; n < 2; ++n) acc[a][b][m][n] = (f32x4){0.f, 0.f, 0.f, 0.f};
    bf16x8 At[4][2], B0[2][2], B1[2][2];
    const char* cA = (const char*)g.A + (size_t)cur.pm * tstepA; const char* cB = (const char*)g.Bt + (size_t)cur.pn * tstepB;
    S.a_ready(cur);
    if constexpr (SP2) {
        PG8_STAGE(PG8_SB(0, 0), cB, voffB); PG8_STAGE(PG8_SB(0, 1), cB + hstepB, voffB); PG8_STAGE(PG8_SA(0, 0), cA, voffA); PG8_STAGE(PG8_SA(0, 1), cA + hstepA, voffA);
        if (wr == 1) PG8_BAR;
        PG8_WAIT_V(2); PG8_BAR;
        PG8_STAGE(PG8_SB(1, 0), cB + kstep, voffB); PG8_STAGE(PG8_SA(1, 0), cA + kstep, voffA); PG8_STAGE(PG8_SB(1, 1), cB + hstepB + kstep, voffB);
        PG8_WAIT_V(6); PG8_BAR;
    } else {
        PG8_STAGE(PG8_SB(0, 0), cB, voffB); PG8_STAGE(PG8_SA(0, 0), cA, voffA); PG8_STAGE(PG8_SB(0, 1), cB + hstepB, voffB); PG8_STAGE(PG8_SA(0, 1), cA + hstepA, voffA);
        if (wr == 1) PG8_BAR;
        PG8_WAIT_V(4); PG8_BAR;
        PG8_STAGE(PG8_SB(1, 0), cB + kstep, voffB); PG8_STAGE(PG8_SA(1, 0), cA + kstep, voffA); PG8_STAGE(PG8_SB(1, 1), cB + hstepB + kstep, voffB);
        PG8_WAIT_V(6); PG8_BAR;
    }
    for (;;) {
        const bool has_next = S.next(ui + 1, nxt);
        const char* nA = has_next ? (const char*)g.A + (size_t)nxt.pm * tstepA : cA; const char* nB = has_next ? (const char*)g.Bt + (size_t)nxt.pn * tstepB : cB;
        for (int t = 0; t < nt; t += 2) {
            if constexpr (Epi::KSCALE) { if (t == 16 || t == 24) {
                const PG8_LAS float* xt = (const PG8_LAS float*)(lds + STAGE_BYTES) + (ui & 1) * 512 + (t == 24 ? 1 : 0) + (wr * 64 + fr) * 2;
#pragma unroll
                for (int ai = 0; ai < 2; ++ai)
#pragma unroll
                    for (int m = 0; m < 4; ++m) { const float f = xt[(ai * HALF + m * 16) * 2];
#pragma unroll
                        for (int bj = 0; bj < 2; ++bj)
#pragma unroll
                            for (int n = 0; n < 2; ++n) acc[ai][bj][m][n] *= f; } } }
            const bool last = (t == nt - 2);
            const char* a1 = cA + (size_t)(t + 1) * kstep;
            const char* a2 = last ? nA : cA + (size_t)(t + 2) * kstep; const char* b2 = last ? nB : cB + (size_t)(t + 2) * kstep;
            const char* a3 = a2 + kstep; const char* b3 = b2 + kstep;
            if (last && has_next) S.a_ready(nxt);
            if constexpr (SP2) {
            PG8_LDB(B0, 0, 0); PG8_LDB(B1, 0, 1); PG8_SCHED; PG8_LDA(At, 0, 0); PG8_STAGE(PG8_SA(1, 1), a1 + hstepA, voffA);
            PG8_WAIT_V(8); PG8_WAIT_L(0); PG8_BAR; PG8_MMA(0, 0, At, B0); PG8_MMA(0, 1, At, B1); PG8_BAR; PG8_SCHED;
            PG8_LDA(At, 0, 1); PG8_STAGE(PG8_SB(0, 0), b2, voffB); PG8_STAGE(PG8_SB(0, 1), b2 + hstepB, voffB); PG8_STAGE(PG8_SA(0, 0), a2, voffA);
            PG8_WAIT_V(8); PG8_WAIT_L(0); PG8_BAR; PG8_MMA(1, 0, At, B0); PG8_MMA(1, 1, At, B1); PG8_BAR; PG8_SCHED;
            PG8_LDB(B0, 1, 0); PG8_LDB(B1, 1, 1); PG8_SCHED; PG8_LDA(At, 1, 0); PG8_STAGE(PG8_SA(0, 1), a2 + hstepA, voffA);
            PG8_WAIT_V(8); PG8_WAIT_L(0); PG8_BAR; PG8_MMA(0, 0, At, B0); PG8_MMA(0, 1, At, B1); PG8_BAR; PG8_SCHED;
            PG8_LDA(At, 1, 1); PG8_STAGE(PG8_SB(1, 0), b3, voffB); PG8_STAGE(PG8_SB(1, 1), b3 + hstepB, voffB); PG8_STAGE(PG8_SA(1, 0), a3, voffA);
            PG8_WAIT_V(8); PG8_WAIT_L(0); PG8_BAR; PG8_MMA(1, 0, At, B0); PG8_MMA(1, 1, At, B1); PG8_BAR; PG8_SCHED;
            } else {
            PG8_LDB(B0, 0, 0); PG8_SCHED; PG8_LDA(At, 0, 0); PG8_STAGE(PG8_SA(1, 1), a1 + hstepA, voffA);
            PG8_WAIT_L(8); PG8_BAR; PG8_WAIT_L(0); PG8_MMA(0, 0, At, B0); PG8_BAR; PG8_SCHED;
            PG8_LDB(B1, 0, 1); PG8_STAGE(PG8_SB(0, 0), b2, voffB);
            PG8_BAR; PG8_WAIT_L(0); PG8_MMA(0, 1, At, B1); PG8_BAR;
            PG8_LDA(At, 0, 1); PG8_STAGE(PG8_SA(0, 0), a2, voffA);
            PG8_BAR; PG8_WAIT_L(0); PG8_MMA(1, 0, At, B0); PG8_BAR; PG8_SCHED;
            PG8_STAGE(PG8_SB(0, 1), b2 + hstepB, voffB);
            PG8_WAIT_V(6); PG8_BAR; PG8_MMA(1, 1, At, B1); PG8_BAR;
            PG8_LDB(B0, 1, 0); PG8_SCHED; PG8_LDA(At, 1, 0); PG8_STAGE(PG8_SA(0, 1), a2 + hstepA, voffA);
            PG8_WAIT_L(8); PG8_BAR; PG8_WAIT_L(0); PG8_MMA(0, 0, At, B0); PG8_BAR; PG8_SCHED;
            PG8_LDB(B1, 1, 1); PG8_STAGE(PG8_SB(1, 0), b3, voffB);
            PG8_BAR; PG8_WAIT_L(0); PG8_MMA(0, 1, At, B1); PG8_BAR;
            PG8_LDA(At, 1, 1); PG8_STAGE(PG8_SA(1, 0), a3, voffA);
            PG8_BAR; PG8_WAIT_L(0); PG8_MMA(1, 0, At, B0); PG8_BAR; PG8_SCHED;
            PG8_STAGE(PG8_SB(1, 1), b3 + hstepB, voffB);
            PG8_WAIT_V(6); PG8_BAR; PG8_MMA(1, 1, At, B1); PG8_BAR;
            }
        }
        if constexpr (ALIGN_EPI) { if (wr == 0) PG8_BAR; }
        if constexpr (!Epi::AFTER_DRAIN) { E(acc, cur, wr, wc, fr, fq); S.done(cur); if constexpr (Epi::KSCALE) { Unit u2; if (S.next(ui + 2, u2)) ((PG8_LAS float*)(lds + STAGE_BYTES))[(ui & 1) * 512 + tid] = E.rt[(size_t)u2.pm * 512 + tid]; } }
        if (!has_next) break;
#pragma unroll
        for (int a = 0; a < 2; ++a)
#pragma unroll
            for (int b = 0; b < 2; ++b)
#pragma unroll
                for (int m = 0; m < 4; ++m)
#pragma unroll
                    for (int n = 0; n < 2; ++n) acc[a][b][m][n] = (f32x4){0.f, 0.f, 0.f, 0.f};
        cur = nxt; cA = nA; cB = nB; ++ui;
        if constexpr (ALIGN_EPI) { if (wr == 1) PG8_BAR; }
    }
    PG8_WAIT_V(0);
    if constexpr (!ALIGN_EPI) { if (wr == 0) PG8_BAR; }
    PG8_BAR;
    if constexpr (Epi::AFTER_DRAIN) { E.fused(acc, cur, wr, wc, fr, fq, lds, wid, lane); S.done(cur); }
#undef PG8_SA
#undef PG8_SB
#undef PG8_STAGE
#undef PG8_LDA
#undef PG8_LDB
#undef PG8_MMA
#undef PG8_WAIT_V
#undef PG8_WAIT_L
#undef PG8_BAR
#undef PG8_SCHED
}
}

constexpr int NWAVES = 8;
constexpr int SEQ = 16384, DM = 2048, INW = 4096, DFF = 8192, NMEM = 256;
constexpr int NAW = 1024, SSMW = 512, MEMW = 512, NGRP = 32, NST = 64, NCHK = 256  , UPITCH = 1280;
constexpr float EPS = 1e-6f;
constexpr size_t MiB = 1u << 20;
constexpr size_t WS_CTL = 0, CTL_ZERO_BYTES = 1 * MiB;
constexpr size_t WS_W2T = 1 * MiB;
constexpr size_t WS_HID = 33 * MiB;
constexpr size_t WS_QN = 33 * MiB, WS_KN = 65 * MiB, WS_VN = 97 * MiB;
constexpr size_t WS_QM = 129 * MiB;
constexpr size_t WS_U = 145 * MiB;
constexpr size_t WS_BTD = 165 * MiB;
constexpr size_t WS_PM = 245 * MiB;
constexpr size_t WS_SLOC = 261 * MiB;
constexpr size_t WS_YG = 490 * MiB;
constexpr size_t WS_KVM = 285 * MiB;
constexpr size_t WS_MEMN = 484 * MiB;
constexpr size_t WS_WIN = 289 * MiB;
constexpr size_t WS_WOUT = 305 * MiB;
constexpr size_t WS_WFF1 = 313 * MiB;
constexpr size_t WS_WGLU = 345 * MiB;
constexpr size_t WS_WKV = 346 * MiB;
constexpr size_t WS_XN = 350 * MiB;
constexpr size_t WS_Y = 414 * MiB;
constexpr size_t WS_A64 = 483 * MiB;
constexpr size_t WS_XS = 487 * MiB;
constexpr size_t WS_SSQ = 488 * MiB;
constexpr size_t WS_RT = 489 * MiB;
constexpr size_t WS_RS1 = 486 * MiB;
constexpr size_t WS_END = 512 * MiB;
constexpr int CW_TMO = 0, CW_BAR = 4096, CW_Q0 = 8192, CW_Q2 = 8448, CW_KVD = 8320, CW_RDY = 12288, CW_PAN = 16384, CW_GRP = 24576;

constexpr int RING_OFF = 0, RING_BYTES = 131072, XTAB_OFF = RING_BYTES  ;
constexpr int LDSCTL_OFF = RING_BYTES + 8192, MISC_OFF = LDSCTL_OFF + 320;
constexpr int LDS_BYTES = 163840;

#define GAS __attribute__((address_space(1)))
#define LAS __attribute__((address_space(3)))
typedef unsigned short bf16;
typedef unsigned v4u __attribute__((ext_vector_type(4)));
typedef float f32x4 __attribute__((ext_vector_type(4)));
typedef short bf16x8 __attribute__((ext_vector_type(8)));
typedef GAS unsigned gu32;
#define RLX_AGENT __ATOMIC_RELAXED, __HIP_MEMORY_SCOPE_AGENT
#define LDS_WAIT() asm volatile("s_waitcnt lgkmcnt(0)" ::: "memory")
#define VM_WAIT() asm volatile("s_waitcnt vmcnt(0)" ::: "memory")
__device__ __forceinline__ unsigned f2bf(float f) { unsigned u = __builtin_bit_cast(unsigned, f); return (u + 0x7fffu + ((u >> 16) & 1u)) >> 16; }
__device__ __forceinline__ unsigned pk2(float lo, float hi) { return f2bf(lo) | (f2bf(hi) << 16); }
__device__ __forceinline__ float bflo(unsigned w) { return __uint_as_float(w << 16); }
__device__ __forceinline__ float bfhi(unsigned w) { return __uint_as_float(w & 0xffff0000u); }

#define XB_TMO      128
#define XB_XCNT(j)  (256  + 64 * (j))
#define XB_XSUB(j)  (1280 + 64 * (j))
#define XB_XGEN(j)  (2304 + 64 * (j))
#define XB_TOP      3328
#define XB_TOPGEN   3392
#define XCD_BAR_WORDS 3456
#define XB_SPIN_CAP (1u << 18)

__device__ __forceinline__ unsigned xb_ld(unsigned* p)              { return __hip_atomic_load(p, __ATOMIC_RELAXED, __HIP_MEMORY_SCOPE_AGENT); }
__device__ __forceinline__ unsigned xb_add(unsigned* p, unsigned v) { return __hip_atomic_fetch_add(p, v, __ATOMIC_RELAXED, __HIP_MEMORY_SCOPE_AGENT); }
__device__ __forceinline__ unsigned xb_xcc_id() { return (unsigned)__builtin_amdgcn_s_getreg((3 << 11) | 20) & 0xFu; }
#define XB_SPIN(cond, bar) do { unsigned _sp = 0; while (cond) { __builtin_amdgcn_s_sleep(1); \
    if ((++_sp & 255u) == 0u) { if (xb_ld(&(bar)[XB_TMO])) break; if (_sp > XB_SPIN_CAP) { atomicAdd(&(bar)[XB_TMO], 1u); break; } } } } while (0)

struct XcdBarrier {
    unsigned* bar; unsigned x;
    volatile LAS unsigned* st;
};

__device__ __forceinline__ XcdBarrier xcd_barrier_post(unsigned* bar, volatile LAS unsigned* st) {
    XcdBarrier b; b.bar = bar; b.x = xb_xcc_id(); b.st = st;
    if (threadIdx.x == 0) (void)xb_add(&bar[XB_XCNT(b.x)], 1u);
    return b;
}
__device__ __forceinline__ void xcd_barrier_complete(unsigned* bar, unsigned x, unsigned& nloc, unsigned& nx) {
    const unsigned G = gridDim.x * gridDim.y * gridDim.z;
    unsigned sum, cnt, mine, sp = 0u;
    for (;;) {
        sum = 0u; cnt = 0u; mine = 0u;
#pragma unroll
        for (unsigned j = 0; j < 16; ++j) { const unsigned c = xb_ld(&bar[XB_XCNT(j)]); sum += c; cnt += (c > 0u) ? 1u : 0u; mine = (j == x) ? c : mine; }
        if (sum == G) break;
        __builtin_amdgcn_s_sleep(1);
        if ((++sp & 255u) == 0u) { if (xb_ld(&bar[XB_TMO])) break; if (sp > XB_SPIN_CAP) { atomicAdd(&bar[XB_TMO], 1u); break; } }
    }
    nloc = mine > 0u ? mine : 1u; nx = cnt > 0u ? cnt : 1u;
}

__device__ __forceinline__ void xcd_barrier(const XcdBarrier& b) {
    asm volatile("s_waitcnt vmcnt(0)" ::: "memory");
    __syncthreads();
    if (threadIdx.x == 0) {
        unsigned* bar = b.bar;
        __builtin_amdgcn_s_waitcnt(0);
        unsigned nloc = b.st[0], nx = b.st[1];
        if (nloc == 0u) { xcd_barrier_complete(bar, b.x, nloc, nx); b.st[0] = nloc; b.st[1] = nx; }
        const unsigned old = xb_add(&bar[XB_XSUB(b.x)], 1u);
        const unsigned gen = old / nloc;
        if (old + 1u == (gen + 1u) * nloc) {
            __builtin_amdgcn_fence(__ATOMIC_RELEASE, "agent");
            asm volatile("s_waitcnt vmcnt(0)" ::: "memory");
            const unsigned og = xb_add(&bar[XB_TOP], 1u);
            const unsigned tg = og / nx;
            if (og + 1u == (tg + 1u) * nx) xb_add(&bar[XB_TOPGEN], 1u);
            else XB_SPIN(xb_ld(&bar[XB_TOPGEN]) == tg, bar);
            __builtin_amdgcn_fence(__ATOMIC_ACQUIRE, "agent");
            xb_add(&bar[XB_XGEN(b.x)], 1u);
            asm volatile("s_waitcnt vmcnt(0)" ::: "memory");
        } else {
            XB_SPIN(xb_ld(&bar[XB_XGEN(b.x)]) == gen, bar);
            __builtin_amdgcn_fence(__ATOMIC_ACQUIRE, "agent");
            asm volatile("s_waitcnt vmcnt(0)" ::: "memory");
        }
    }
    __syncthreads();
}

namespace att {
using bf16x8 = __attribute__((ext_vector_type(8))) short;
using s16x4  = __attribute__((ext_vector_type(4))) short;
using f32x16 = __attribute__((ext_vector_type(16))) float;
using u32x4  = __attribute__((ext_vector_type(4))) unsigned;
typedef unsigned short bf16;
constexpr int   D = 128, NW = 8, QBLK = 32, KVBLK = 64;
constexpr float SCALE = 0.088388347648318440f;
constexpr float THR = 8.f;
constexpr int SHM_V = KVBLK * D * 2, SHM_K = KVBLK * D * 2;
constexpr int OFF_K = 2 * SHM_V, OFF_WS = 2 * SHM_V + 2 * SHM_K, OFF_TAB = OFF_WS + NW * 64 * 4, ATT_LDS_BYTES = OFF_TAB + (864 + 576) * 4;
#define KSWZ(row, colB) ((row) * 256 + ((colB) ^ (((row) & 7) << 4)))
#define SBAR() __builtin_amdgcn_sched_barrier(0)
__device__ __forceinline__ int crow(int r, int hi) { return (r & 3) + 8 * (r >> 2) + 4 * hi; }
__device__ __forceinline__ unsigned cvtpk(float lo, float hi) { unsigned r; asm volatile("v_cvt_pk_bf16_f32 %0, %1, %2" : "=v"(r) : "v"(lo), "v"(hi)); return r; }
__device__ __forceinline__ void partialSM(f32x16& p0, f32x16& p1, float& m_reg, float& mn, float& alpha) {
  constexpr float C = SCALE * 1.4426950408889634f;
  float pmax = p0[0]; for (int r = 1; r < 16; ++r) pmax = fmaxf(pmax, p0[r]); for (int r = 0; r < 16; ++r) pmax = fmaxf(pmax, p1[r]);
  { auto rr = __builtin_amdgcn_permlane32_swap(__float_as_uint(pmax), __float_as_uint(pmax), false, false);
    pmax = fmaxf(__uint_as_float(rr[0]), __uint_as_float(rr[1])); }
  if (__builtin_expect(__all(pmax - m_reg <= THR / SCALE), 1)) { mn = m_reg; alpha = 1.f; }
  else { mn = fmaxf(m_reg, pmax); alpha = __builtin_amdgcn_exp2f((m_reg - mn) * C); m_reg = mn; }
  float mnC = -mn * C;
  for (int r = 0; r < 16; ++r) p0[r] = fmaf(p0[r], C, mnC); for (int r = 0; r < 16; ++r) p1[r] = fmaf(p1[r], C, mnC);
  for (int r = 0; r < 16; ++r) p0[r] = __builtin_amdgcn_exp2f(p0[r]);
}
__device__ __forceinline__ void finishSM(f32x16& p0, f32x16& p1, float alpha, float& l_reg, bf16x8& pa0, bf16x8& pa1, bf16x8& pa2, bf16x8& pa3) {
  for (int r = 0; r < 16; ++r) p1[r] = __builtin_amdgcn_exp2f(p1[r]);
  float ps = 0; for (int r = 0; r < 16; ++r) ps += p0[r]; for (int r = 0; r < 16; ++r) ps += p1[r];
  { auto rr = __builtin_amdgcn_permlane32_swap(__float_as_uint(ps), __float_as_uint(ps), false, false);
    ps = __uint_as_float(rr[0]) + __uint_as_float(rr[1]); }
  l_reg = l_reg * alpha + ps;
#define PK4(P, BASE, OUT) do { unsigned a0 = cvtpk(P[BASE + 0], P[BASE + 1]), a1 = cvtpk(P[BASE + 2], P[BASE + 3]);   \
    unsigned b0 = cvtpk(P[BASE + 4], P[BASE + 5]), b1 = cvtpk(P[BASE + 6], P[BASE + 7]);                              \
    auto r0 = __builtin_amdgcn_permlane32_swap(a0, b0, false, false); auto r1 = __builtin_amdgcn_permlane32_swap(a1, b1, false, false); \
    u32x4 w = {r0[0], r1[0], r0[1], r1[1]}; OUT = *reinterpret_cast<bf16x8*>(&w); } while (0)
  PK4(p0, 0, pa0); PK4(p0, 8, pa1); PK4(p1, 0, pa2); PK4(p1, 8, pa3);
#undef PK4
}
__device__ __forceinline__ void qkt(f32x16& p0, f32x16& p1, const bf16* Ks, const bf16x8* qr, int r32, int hi) {
  p0 = f32x16{}; p1 = f32x16{};
  for (int d0 = 0; d0 < 8; ++d0) { int cb = (d0 * 16 + hi * 8) * 2;
    bf16x8 b0 = *reinterpret_cast<const bf16x8*>((const char*)Ks + KSWZ(r32, cb));
    bf16x8 b1 = *reinterpret_cast<const bf16x8*>((const char*)Ks + KSWZ(32 + r32, cb));
    p0 = __builtin_amdgcn_mfma_f32_32x32x16_bf16(b0, qr[d0], p0, 0, 0, 0);
    p1 = __builtin_amdgcn_mfma_f32_32x32x16_bf16(b1, qr[d0], p1, 0, 0, 0); }
}
__device__ __forceinline__ int v_st(int k, int c) { const int kk = (k & ~0xC) | ((k & 4) << 1) | ((k & 8) >> 1); return ((kk >> 3) * 4 + (c >> 5)) * 512 + ((kk & 7) * 32 + (c & 31)) * 2; }
__device__ __forceinline__ int v_rd_base(int lane) { return ((lane & 3) << 3) | (((lane >> 2) & 3) << 6) | (((lane >> 4) & 1) << 5) | (((lane >> 5) & 1) << 8); }
constexpr int v_rd_off(int d0, int ks, int half) { return d0 * 512 + ks * 4096 + half * 2048; }
template <int OFF> __device__ __forceinline__ s16x4 tr_read(int vb) {
  s16x4 r; asm volatile("ds_read_b64_tr_b16 %0, %1 offset:%2" : "=&v"(r) : "v"(vb), "i"(OFF) : "memory"); return r;
}
template <int D0> __device__ __forceinline__ void pv_one(f32x16& od, int vb, bf16x8 pa0, bf16x8 pa1, bf16x8 pa2, bf16x8 pa3) {
  const s16x4 l0 = tr_read<v_rd_off(D0, 0, 0)>(vb), h0 = tr_read<v_rd_off(D0, 0, 1)>(vb), l1 = tr_read<v_rd_off(D0, 1, 0)>(vb), h1 = tr_read<v_rd_off(D0, 1, 1)>(vb);
  const s16x4 l2 = tr_read<v_rd_off(D0, 2, 0)>(vb), h2 = tr_read<v_rd_off(D0, 2, 1)>(vb), l3 = tr_read<v_rd_off(D0, 3, 0)>(vb), h3 = tr_read<v_rd_off(D0, 3, 1)>(vb);
  asm volatile("s_waitcnt lgkmcnt(0)" ::: "memory"); SBAR();
#define PK(L, H) (bf16x8){L[0], L[1], L[2], L[3], H[0], H[1], H[2], H[3]}
  od = __builtin_amdgcn_mfma_f32_32x32x16_bf16(pa0, PK(l0, h0), od, 0, 0, 0);
  od = __builtin_amdgcn_mfma_f32_32x32x16_bf16(pa1, PK(l1, h1), od, 0, 0, 0);
  od = __builtin_amdgcn_mfma_f32_32x32x16_bf16(pa2, PK(l2, h2), od, 0, 0, 0);
  od = __builtin_amdgcn_mfma_f32_32x32x16_bf16(pa3, PK(l3, h3), od, 0, 0, 0);
#undef PK
}
__device__ __forceinline__ void pv_d0(f32x16* o, int vb, bf16x8 pa0, bf16x8 pa1, bf16x8 pa2, bf16x8 pa3) {
  pv_one<0>(o[0], vb, pa0, pa1, pa2, pa3); pv_one<1>(o[1], vb, pa0, pa1, pa2, pa3); pv_one<2>(o[2], vb, pa0, pa1, pa2, pa3); pv_one<3>(o[3], vb, pa0, pa1, pa2, pa3);
}
template <bool NA, int LDQ>
__device__ __forceinline__ unsigned attn_unit(char* lds, const bf16* __restrict__ Qb, const bf16* __restrict__ Kh, const bf16* __restrict__ Vh, bf16* __restrict__ Ob,
                                          int nt, int kt0, int r0, const float* __restrict__ rpb, float* __restrict__ ssq, int ssq_stride, unsigned* next_head) {
  constexpr int LDK = 1024, LDO = 2048;
  int tid_ = threadIdx.x; asm volatile("" : "+v"(tid_));
  const int tid = tid_, wid = tid >> 6, lane = tid & 63, r32 = lane & 31, hi = lane >> 5;
  bf16* V_lds = (bf16*)lds; bf16* K_lds = (bf16*)(lds + OFF_K);
  float* wsf = (float*)(lds + OFF_WS) + wid * 64; float* li_l = wsf; float* al_l = wsf + 32;
  float* tab = (float*)(lds + OFF_TAB);
  float m_reg = -1e30f, l_reg = 0; f32x16 o[4] = {}; bf16x8 qr[8];
  const bf16* Qw = Qb + (long)(wid * QBLK + r32) * LDQ + hi * 8;
#pragma unroll
  for (int d0 = 0; d0 < 8; ++d0) qr[d0] = *reinterpret_cast<const bf16x8*>(Qw + d0 * 16);
  const int sr = tid >> 4, sc = (tid & 15) * 8, vst0 = v_st(sr, sc), vst1 = v_st(32 + sr, sc);
  const int vb0 = (int)(uintptr_t)V_lds + v_rd_base(lane);
  int rs = 0, t0 = 0, bidx0 = 0;
  if (NA) {
    for (int i = tid; i < 640; i += 512) { const int idx = i - 48; tab[i] = (idx >= 0 && idx < 465) ? rpb[idx] * (1.0f / SCALE) : 0.f; }
    const int r = r0 + (wid >> 1), c = 32 * (wid & 1) + r32;
    rs = min(max(r - 4, 0), 248); const int cs = min(max(c - 8, 0), 48);
    t0 = 4 * hi - cs;
    bidx0 = 48 + (7 - r) * 31 - c + 15 + 4 * hi;
  }
  struct StageRegs { bf16x8 vs0, vs1, ks0, ks1; } sA, sB;
const bf16* Vt = Vh + (long)sr * LDK + sc; const bf16* Kt = Kh + (long)sr * LDK + sc;
#define SLOAD(S, k0) do { const long o_ = (long)__builtin_amdgcn_readfirstlane(k0) * LDK; S.vs0 = *reinterpret_cast<const bf16x8*>(Vt + o_); S.vs1 = *reinterpret_cast<const bf16x8*>(Vt + o_ + 32 * LDK); \
    S.ks0 = *reinterpret_cast<const bf16x8*>(Kt + o_); S.ks1 = *reinterpret_cast<const bf16x8*>(Kt + o_ + 32 * LDK); } while (0)
#define SWRITE(b, S) do { *(bf16x8*)((char*)V_lds + (b) * SHM_V + vst0) = S.vs0; *(bf16x8*)((char*)V_lds + (b) * SHM_V + vst1) = S.vs1; const int kc_ = sc * 2;               \
    *(bf16x8*)((char*)K_lds + (b) * SHM_K + KSWZ(sr, kc_)) = S.ks0; *(bf16x8*)((char*)K_lds + (b) * SHM_K + KSWZ(32 + sr, kc_)) = S.ks1; } while (0)
#define TILE(buf, kr) do { const bool active = NA ? ((kr) >= rs && (kr) <= rs + 7) : true;        \
    if (active) { f32x16 p0, p1; float mn, alpha; bf16x8 pa0, pa1, pa2, pa3; \
      SBAR(); qkt(p0, p1, (const bf16*)((const char*)K_lds + (buf) * SHM_K), qr, r32, hi); \
      if (NA) { const int bi = bidx0 + (kr) * 31; \
        _Pragma("unroll") for (int r = 0; r < 16; ++r) { const int kofs = (r & 3) + 8 * (r >> 2); \
          { const float b = tab[bi + kofs]; p0[r] = ((unsigned)(t0 + kofs) < 16u) ? p0[r] + b : -__builtin_inff(); } \
          { const float b = tab[bi + 32 + kofs]; p1[r] = ((unsigned)(t0 + 32 + kofs) < 16u) ? p1[r] + b : -__builtin_inff(); } } } \
      partialSM(p0, p1, m_reg, mn, alpha); \
      if (__any(alpha < 1.f)) { if (hi == 0) al_l[r32] = alpha; asm volatile("s_waitcnt lgkmcnt(0)" ::: "memory"); \
        _Pragma("unroll") for (int d = 0; d < 4; ++d) _Pragma("unroll") for (int r = 0; r < 16; ++r) o[d][r] *= al_l[crow(r, hi)]; } \
      finishSM(p0, p1, alpha, l_reg, pa0, pa1, pa2, pa3); SBAR(); \
      pv_d0(o, vb0 + (buf) * SHM_V, pa0, pa1, pa2, pa3); } } while (0)
  const int klast = kt0 + nt - 1;
  SLOAD(sA, kt0 * 64); SLOAD(sB, (kt0 + 1) * 64); SWRITE(0, sA); SLOAD(sA, min(kt0 + 2, klast) * 64); __syncthreads();
  for (int j = 0; j < nt; j += 2) {
    const int kr = kt0 + j;
    TILE(0, kr);
    SWRITE(1, sB); SLOAD(sB, min(kr + 3, klast) * 64);
    __syncthreads();
    TILE(1, kr + 1);
    SWRITE(0, sA); SLOAD(sA, min(kr + 4, klast) * 64);
    __syncthreads();
  }
  const unsigned next_ticket = (tid == 0) ? __hip_atomic_fetch_add(next_head, 1u, __ATOMIC_RELAXED, __HIP_MEMORY_SCOPE_AGENT) : 0u;
  if (hi == 0) li_l[r32] = l_reg; asm volatile("s_waitcnt lgkmcnt(0)" ::: "memory");
  float rli[16];
#pragma unroll
  for (int r = 0; r < 16; ++r) rli[r] = __builtin_amdgcn_rcpf(li_l[crow(r, hi)]);
#pragma unroll
  for (int r = 0; r < 16; ++r) { float v = 0.f;
#pragma unroll
    for (int d0 = 0; d0 < 4; ++d0) { const float t = o[d0][r] * rli[r]; v += t * t; }
    v += __shfl_xor(v, 1); v += __shfl_xor(v, 2); v += __shfl_xor(v, 4); v += __shfl_xor(v, 8); v += __shfl_xor(v, 16);
    if (r32 == 0) ssq[(long)(wid * QBLK + crow(r, hi)) * ssq_stride] = v; }
  bf16* Ow = Ob + (long)(wid * QBLK) * LDO;
  const bool odd = (r32 & 1) != 0;
#pragma unroll
  for (int r = 0; r < 16; r += 2) { const int orow = crow(odd ? r + 1 : r, hi);
#pragma unroll
    for (int d0 = 0; d0 < 4; ++d0) { const float mine0 = o[d0][r] * rli[r], mine1 = o[d0][r + 1] * rli[r + 1];
      const float got = __shfl_xor(odd ? mine0 : mine1, 1);
      const unsigned w = odd ? cvtpk(got, mine1) : cvtpk(mine0, got);
      *(unsigned*)(Ow + (long)orow * LDO + d0 * 32 + (r32 & ~1)) = w; } }
#undef TILE
#undef SLOAD
#undef SWRITE
  return next_ticket;
}
__device__ __forceinline__ void partialSM1(f32x16& p0, float& m_reg, float& mn, float& alpha) {
  constexpr float C = SCALE * 1.4426950408889634f;
  float pmax = p0[0]; for (int r = 1; r < 16; ++r) pmax = fmaxf(pmax, p0[r]);
  { auto rr = __builtin_amdgcn_permlane32_swap(__float_as_uint(pmax), __float_as_uint(pmax), false, false);
    pmax = fmaxf(__uint_as_float(rr[0]), __uint_as_float(rr[1])); }
  if (__builtin_expect(__all(pmax - m_reg <= THR / SCALE), 1)) { mn = m_reg; alpha = 1.f; }
  else { mn = fmaxf(m_reg, pmax); alpha = __builtin_amdgcn_exp2f((m_reg - mn) * C); m_reg = mn; }
  const float mnC = -mn * C;
  for (int r = 0; r < 16; ++r) p0[r] = __builtin_amdgcn_exp2f(fmaf(p0[r], C, mnC));
}
__device__ __forceinline__ void finishSM1(f32x16& p0, float alpha, float& l_reg, bf16x8& pa0, bf16x8& pa1) {
  float ps = 0; for (int r = 0; r < 16; ++r) ps += p0[r];
  { auto rr = __builtin_amdgcn_permlane32_swap(__float_as_uint(ps), __float_as_uint(ps), false, false);
    ps = __uint_as_float(rr[0]) + __uint_as_float(rr[1]); }
  l_reg = l_reg * alpha + ps;
#define PK4(P, BASE, OUT) do { unsigned a0 = cvtpk(P[BASE + 0], P[BASE + 1]), a1 = cvtpk(P[BASE + 2], P[BASE + 3]);   \
    unsigned b0 = cvtpk(P[BASE + 4], P[BASE + 5]), b1 = cvtpk(P[BASE + 6], P[BASE + 7]);                              \
    auto r0 = __builtin_amdgcn_permlane32_swap(a0, b0, false, false); auto r1 = __builtin_amdgcn_permlane32_swap(a1, b1, false, false); \
    u32x4 w = {r0[0], r1[0], r0[1], r1[1]}; OUT = *reinterpret_cast<bf16x8*>(&w); } while (0)
  PK4(p0, 0, pa0); PK4(p0, 8, pa1);
#undef PK4
}
template <int D0> __device__ __forceinline__ void pv_one2(f32x16& od, int vb, bf16x8 pa0, bf16x8 pa1) {
  const s16x4 l0 = tr_read<v_rd_off(D0, 0, 0)>(vb), h0 = tr_read<v_rd_off(D0, 0, 1)>(vb), l1 = tr_read<v_rd_off(D0, 1, 0)>(vb), h1 = tr_read<v_rd_off(D0, 1, 1)>(vb);
  asm volatile("s_waitcnt lgkmcnt(0)" ::: "memory"); SBAR();
#define PK(L, H) (bf16x8){L[0], L[1], L[2], L[3], H[0], H[1], H[2], H[3]}
  od = __builtin_amdgcn_mfma_f32_32x32x16_bf16(pa0, PK(l0, h0), od, 0, 0, 0);
  od = __builtin_amdgcn_mfma_f32_32x32x16_bf16(pa1, PK(l1, h1), od, 0, 0, 0);
#undef PK
}
constexpr int NA_TAB = 864 + 576;
__device__ __forceinline__ unsigned na_unit(char* lds, const bf16* __restrict__ Qb, const bf16* __restrict__ Kh, const bf16* __restrict__ Vh, bf16* __restrict__ Ob,
                                        int nt, int kt0, int kr_hi, int r0, const float* __restrict__ rpb, float* __restrict__ ssq, unsigned* next_head) {
  constexpr int LDQ = 1024, LDK = 1024, LDO = 2048;
  int tid_ = threadIdx.x; asm volatile("" : "+v"(tid_));
  const int tid = tid_, wid = __builtin_amdgcn_readfirstlane(tid >> 6), lane = tid & 63, r32 = lane & 31, hi = lane >> 5;
  constexpr int NA_OFF_K = 4 * SHM_V, NA_OFF_WS = 4 * SHM_V + 4 * SHM_K, NA_OFF_TAB = NA_OFF_WS + NW * 64 * 4;
  bf16* V_lds = (bf16*)lds; bf16* K_lds = (bf16*)(lds + NA_OFF_K);
  float* wsf = (float*)(lds + NA_OFF_WS) + wid * 64; float* li_l = wsf; float* al_l = wsf + 32;
  float* tab = (float*)(lds + NA_OFF_TAB);
  float m_reg = -1e30f, l_reg = 0; f32x16 o[4] = {}; bf16x8 qr[8];
  const int kb = wid <= 2 ? 0 : (wid <= 4 ? 16 : 32);
  const int qrow = r32 >> 3, qcol = 8 * wid + (r32 & 7);
  const bf16* Qw = Qb + (long)(qrow * 64 + qcol) * LDQ + hi * 8;
#pragma unroll
  for (int d0 = 0; d0 < 8; ++d0) qr[d0] = *reinterpret_cast<const bf16x8*>(Qw + d0 * 16);
  const int sr = tid >> 4, sc = (tid & 15) * 8, vst0 = v_st(sr, sc), vst1 = v_st(32 + sr, sc);
  const int vb0 = (int)(uintptr_t)V_lds + v_rd_base(lane) + (kb >> 4) * 4096;
  const bool edge_unit = (r0 == 0) || (r0 == 252);
  for (int i = tid; i < 864 + 576; i += 512) { float v = -__builtin_inff();
    if (i < 864) { const int row = i / 48, dc = i % 48 - 23, dr = row - 7; const bool ok = (edge_unit ? row <= 14 : (dr >= -4 && dr <= 3)) && dc >= -8 && dc <= 7; if (ok) v = rpb[row * 31 + dc + 15] * (1.0f / SCALE); }
    else { const int jj = i - 864, row = jj >> 5, col = jj & 31, dr = row - 7; const bool ok = (edge_unit ? row <= 14 : (dr >= -4 && dr <= 3)) && col <= 30; if (ok) v = rpb[row * 31 + col] * (1.0f / SCALE); }
    tab[i] = v; }
  const int rq = r0 + qrow;
  const int wt = wid == 0 ? 1 : (wid == 7 ? 2 : 0);
  const int bidx0 = wt == 0 ? (7 - rq) * 48 + kb + 4 * hi - qcol + 23 : 864 + (7 - rq) * 32 + kb + 4 * hi - qcol + 15;
  const int bpitch = wt == 0 ? 48 : 32;
  const bf16* Vt = Vh + (long)sr * LDK + sc; const bf16* Kt = Kh + (long)sr * LDK + sc;
  bf16x8 vsA0, vsA1, ksA0, ksA1, vsB0, vsB1, ksB0, ksB1;
#define SLOAD(k0) do { const long o_ = (long)__builtin_amdgcn_readfirstlane(k0) * LDK; \
    vsA0 = *reinterpret_cast<const bf16x8*>(Vt + o_); vsA1 = *reinterpret_cast<const bf16x8*>(Vt + o_ + 32 * LDK); ksA0 = *reinterpret_cast<const bf16x8*>(Kt + o_); ksA1 = *reinterpret_cast<const bf16x8*>(Kt + o_ + 32 * LDK); \
    vsB0 = *reinterpret_cast<const bf16x8*>(Vt + o_ + 64 * LDK); vsB1 = *reinterpret_cast<const bf16x8*>(Vt + o_ + 96 * LDK); ksB0 = *reinterpret_cast<const bf16x8*>(Kt + o_ + 64 * LDK); ksB1 = *reinterpret_cast<const bf16x8*>(Kt + o_ + 96 * LDK); } while (0)
#define SWRITE(b) do { const int kc_ = sc * 2; \
    *(bf16x8*)((char*)V_lds + (2 * (b)) * SHM_V + vst0) = vsA0; *(bf16x8*)((char*)V_lds + (2 * (b)) * SHM_V + vst1) = vsA1; \
    *(bf16x8*)((char*)K_lds + (2 * (b)) * SHM_K + KSWZ(sr, kc_)) = ksA0; *(bf16x8*)((char*)K_lds + (2 * (b)) * SHM_K + KSWZ(32 + sr, kc_)) = ksA1; \
    *(bf16x8*)((char*)V_lds + (2 * (b) + 1) * SHM_V + vst0) = vsB0; *(bf16x8*)((char*)V_lds + (2 * (b) + 1) * SHM_V + vst1) = vsB1; \
    *(bf16x8*)((char*)K_lds + (2 * (b) + 1) * SHM_K + KSWZ(sr, kc_)) = ksB0; *(bf16x8*)((char*)K_lds + (2 * (b) + 1) * SHM_K + KSWZ(32 + sr, kc_)) = ksB1; } while (0)
#define PINIT(P, KR) do { const int bi = bidx0 + (KR) * bpitch; \
    if (wt == 0) { _Pragma("unroll") for (int r = 0; r < 16; ++r) P[r] = tab[bi + (r & 3) + 8 * (r >> 2)]; } \
    else if (wt == 1) { _Pragma("unroll") for (int r = 0; r < 16; ++r) P[r] = r < 8 ? tab[bi + (r & 3) + 8 * (r >> 2)] : -__builtin_inff(); } \
    else { _Pragma("unroll") for (int r = 0; r < 16; ++r) P[r] = r >= 8 ? tab[bi + (r & 3) + 8 * (r >> 2)] : -__builtin_inff(); } } while (0)
#define QKT(P, SLOT) do { const bf16* Ks = (const bf16*)((const char*)K_lds + (SLOT) * SHM_K); \
    _Pragma("unroll") for (int d0 = 0; d0 < 8; ++d0) { const int cb = (d0 * 16 + hi * 8) * 2; \
      const bf16x8 b0 = *reinterpret_cast<const bf16x8*>((const char*)Ks + KSWZ(kb + r32, cb)); \
      P = __builtin_amdgcn_mfma_f32_32x32x16_bf16(b0, qr[d0], P, 0, 0, 0); } } while (0)
#define SMPV(P, SLOT) do { float mn, alpha; bf16x8 pa0, pa1; partialSM1(P, m_reg, mn, alpha); \
    if (__any(alpha < 1.f)) { if (hi == 0) al_l[r32] = alpha; asm volatile("s_waitcnt lgkmcnt(0)" ::: "memory"); \
      _Pragma("unroll") for (int d = 0; d < 4; ++d) _Pragma("unroll") for (int r = 0; r < 16; ++r) o[d][r] *= al_l[crow(r, hi)]; } \
    finishSM1(P, alpha, l_reg, pa0, pa1); SBAR(); const int vb = vb0 + (SLOT) * SHM_V; \
    pv_one2<0>(o[0], vb, pa0, pa1); pv_one2<1>(o[1], vb, pa0, pa1); pv_one2<2>(o[2], vb, pa0, pa1); pv_one2<3>(o[3], vb, pa0, pa1); } while (0)
  const int nsteps = nt >> 1;
  SLOAD(kt0 * 64); SWRITE(0); __syncthreads();
  for (int st = 0; st < nsteps; ++st) {
    const int b = st & 1, kr = kt0 + 2 * st;
    if (st + 1 < nsteps) SLOAD((kr + 2) * 64);
    const bool validB = kr + 1 <= kr_hi;
    f32x16 pA, pB;
    SBAR();
    PINIT(pA, kr); if (validB) PINIT(pB, kr + 1);
    QKT(pA, 2 * b); if (validB) QKT(pB, 2 * b + 1);
    SMPV(pA, 2 * b);
    if (validB) SMPV(pB, 2 * b + 1);
    if (st + 1 < nsteps) SWRITE(b ^ 1);
    __syncthreads();
  }
#undef PINIT
#undef QKT
#undef SMPV
  const unsigned next_ticket = (tid == 0) ? __hip_atomic_fetch_add(next_head, 1u, __ATOMIC_RELAXED, __HIP_MEMORY_SCOPE_AGENT) : 0u;
  if (hi == 0) li_l[r32] = l_reg; asm volatile("s_waitcnt lgkmcnt(0)" ::: "memory");
  float rli[16];
#pragma unroll
  for (int r = 0; r < 16; ++r) rli[r] = __builtin_amdgcn_rcpf(li_l[crow(r, hi)]);
#pragma unroll
  for (int r = 0; r < 16; ++r) { float v = 0.f;
#pragma unroll
    for (int d0 = 0; d0 < 4; ++d0) { const float t = o[d0][r] * rli[r]; v += t * t; }
    v += __shfl_xor(v, 1); v += __shfl_xor(v, 2); v += __shfl_xor(v, 4); v += __shfl_xor(v, 8); v += __shfl_xor(v, 16);
    const int qi = crow(r, hi);
    if (r32 == 0) ssq[(long)((qi >> 3) * 64 + 8 * wid + (qi & 7)) * 8] = v; }
  const bool odd = (r32 & 1) != 0;
#pragma unroll
  for (int r = 0; r < 16; r += 2) { const int qi = crow(odd ? r + 1 : r, hi); bf16* orow = Ob + (long)((qi >> 3) * 64 + 8 * wid + (qi & 7)) * LDO;
#pragma unroll
    for (int d0 = 0; d0 < 4; ++d0) { const float mine0 = o[d0][r] * rli[r], mine1 = o[d0][r + 1] * rli[r + 1];
      const float got = __shfl_xor(odd ? mine0 : mine1, 1);
      const unsigned w = odd ? cvtpk(got, mine1) : cvtpk(mine0, got);
      *(unsigned*)(orow + d0 * 32 + (r32 & ~1)) = w; } }
#undef SLOAD
#undef SWRITE
  return next_ticket;
}
#undef KSWZ
#undef SBAR
}

struct Frame {
    LAS unsigned char* lds;
    volatile LAS unsigned* MISC;
    gu32* ctl;
    int tid, lane, wave;
    int vcu, G;
    const float* const* in; float* out; unsigned char* ws;
};
__device__ __forceinline__ float wave_sum(float v) {
#pragma unroll
    for (int o = 1; o < 64; o <<= 1) v += __shfl_xor(v, o);
    return v;
}
__device__ __forceinline__ float wave_max(float v) {
#pragma unroll
    for (int o = 1; o < 64; o <<= 1) v = fmaxf(v, __shfl_xor(v, o));
    return v;
}
__device__ __forceinline__ void p0_transpose_item(const float* W, int K, int N, bf16* WT, const float* gain, LAS float* scr, int item, int lane, int kperm = 0) {
    const int nblk = N / 32, kb = item / nblk, nb = item % nblk, k0 = 64 * kb, n0 = 32 * nb;
    const int kd = kperm ? (k0 < 1024 ? k0 : (k0 < 1536 ? k0 + 512 : k0 - 512)) : k0;
    const GAS float* src = (const GAS float*)W + (size_t)(k0 + (lane >> 5)) * N + n0 + (lane & 31);
    float v[32];
#pragma unroll
    for (int i = 0; i < 32; ++i) v[i] = src[(size_t)(2 * i) * N];
    if (gain) {
#pragma unroll
        for (int i = 0; i < 32; ++i) v[i] *= gain[k0 + 2 * i + (lane >> 5)]; }
#pragma unroll
    for (int i = 0; i < 32; ++i) scr[(2 * i + (lane >> 5)) * 33 + (lane & 31)] = v[i];
    LDS_WAIT(); asm volatile("" ::: "memory");
    const int c = lane & 7;
#pragma unroll
    for (int j = 0; j < 4; ++j) { const int n = (lane >> 3) + 8 * j; const LAS float* s = scr + (8 * c) * 33 + n;
        v4u o; o.x = pk2(s[0 * 33], s[1 * 33]); o.y = pk2(s[2 * 33], s[3 * 33]); o.z = pk2(s[4 * 33], s[5 * 33]); o.w = pk2(s[6 * 33], s[7 * 33]);
        *(GAS v4u*)(WT + (size_t)(n0 + n) * K + kd + 8 * c) = o; }
    LDS_WAIT(); asm volatile("" ::: "memory");
}
__device__ __forceinline__ void rms_row_to_bf16(int lane, const float* xrow, bf16* orow) {
    const GAS f32x4* xr = (const GAS f32x4*)xrow + lane;
    f32x4 v[8]; float s = 0.f;
#pragma unroll
    for (int j = 0; j < 8; ++j) { v[j] = xr[64 * j]; s += (v[j].x * v[j].x + v[j].y * v[j].y) + (v[j].z * v[j].z + v[j].w * v[j].w); }
    const float rs = 1.f / sqrtf(wave_sum(s) * (1.f / DM) + EPS);
    GAS unsigned long long* o8 = (GAS unsigned long long*)orow + lane;
#pragma unroll
    for (int j = 0; j < 8; ++j) o8[64 * j] = (unsigned long long)pk2(v[j].x * rs, v[j].y * rs) | ((unsigned long long)pk2(v[j].z * rs, v[j].w * rs) << 32);
}
__device__ __forceinline__ void p0_ssm_group(Frame& F, int g, int ch) {
    typedef float f32x2 __attribute__((ext_vector_type(2)));
    LAS f32x2* PW = (LAS f32x2*)(F.lds);
    LAS f32x2* BB = (LAS f32x2*)(F.lds + 33280);
    LAS f32x2* CC = (LAS f32x2*)(F.lds + 33280 + 8192);
    LAS bf16* KM = (LAS bf16*)(F.lds + 49664);
    const float *lam_re = F.in[5], *lam_im = F.in[6], *log_dt = F.in[7], *b_re = F.in[8], *b_im = F.in[9], *c_re = F.in[10], *c_im = F.in[11], *dd = F.in[12];
    bf16* Pm = (bf16*)(F.ws + WS_PM) + (size_t)g * 256 * 1024;
    bf16* BtD = (bf16*)(F.ws + WS_BTD) + (size_t)g * 1024 * UPITCH;
    f32x2* A64 = (f32x2*)(F.ws + WS_A64);
    const int tid = F.tid;
    const int pairl = tid & 127, kc = 8 * ch + (pairl >> 4), kcp = pairl & 15, quarter = tid >> 7;
    float k0sum = 0.f;
    for (int dir = 0; dir < 2; ++dir) {
        const int dg = dir * NGRP + g;
        const double dt = exp((double)log_dt[dg]);
        for (int e = tid; e < 64 * 65; e += 512) { const int p = e / 65, tau = e % 65;
            const double lr = fmin((double)lam_re[dg * 64 + p], -1e-4), li = (double)lam_im[dg * 64 + p];
            const double mag = exp(tau * dt * lr); const double sn = sin(tau * dt * li), cs = cos(tau * dt * li);
            PW[e] = (f32x2){(float)(mag * cs), (float)(mag * sn)};
            if (tau == 64 && ch == 0) A64[dg * 64 + p] = (f32x2){(float)(mag * cs), (float)(mag * sn)}; }
        for (int e = tid; e < 1024; e += 512) { const int p = e >> 4, c = e & 15;
            const double lr = fmin((double)lam_re[dg * 64 + p], -1e-4), li = (double)lam_im[dg * 64 + p];
            const double mag = exp(dt * lr); const double sn = sin(dt * li), cs = cos(dt * li);
            const double ar = mag * cs - 1.0, ai = mag * sn, den = lr * lr + li * li;
            const double qr = (ar * lr + ai * li) / den, qi = (ai * lr - ar * li) / den;
            const double br = (double)b_re[(size_t)(dg * 64 + p) * 16 + c], bi = (double)b_im[(size_t)(dg * 64 + p) * 16 + c];
            BB[e] = (f32x2){(float)(qr * br - qi * bi), (float)(qr * bi + qi * br)}; }
        for (int e = tid; e < 1024; e += 512) CC[e] = (f32x2){c_re[(size_t)dg * 1024 + e], c_im[(size_t)dg * 1024 + e]};
        __syncthreads();
        { float acc[16];
#pragma unroll
          for (int t = 0; t < 16; ++t) acc[t] = 0.f;
          for (int p = 0; p < 64; ++p) { const f32x2 c = CC[kc * 64 + p], b = BB[p * 16 + kcp]; const float cbr = c.x * b.x - c.y * b.y, cbi = c.x * b.y + c.y * b.x;
#pragma unroll
              for (int t = 0; t < 16; ++t) { const f32x2 w = PW[p * 65 + quarter * 16 + t]; acc[t] += cbr * w.x - cbi * w.y; } }
#pragma unroll
          for (int t = 0; t < 16; ++t) { const int tau = quarter * 16 + t;
              if (tau == 0) k0sum += acc[t];
              else KM[(dir == 0 ? 63 + tau : 63 - tau) * 128 + pairl] = (bf16)f2bf(acc[t]); } }
        for (int it = tid; it < 32 * 64 * 2; it += 512) { const int hc = it & 1, s = (it >> 1) & 63, p = 32 * ch + (it >> 7);
            const f32x2 w = PW[p * 65 + (dir == 0 ? 63 - s : s)]; float re[8], im[8];
#pragma unroll
            for (int j = 0; j < 8; ++j) { const f32x2 b = BB[p * 16 + hc * 8 + j]; re[j] = w.x * b.x - w.y * b.y; im[j] = w.x * b.y + w.y * b.x; }
            v4u o; o.x = pk2(re[0], re[1]); o.y = pk2(re[2], re[3]); o.z = pk2(re[4], re[5]); o.w = pk2(re[6], re[7]);
            *(GAS v4u*)(Pm + (size_t)(dir * 128 + p) * 1024 + s * 16 + hc * 8) = o;
            o.x = pk2(im[0], im[1]); o.y = pk2(im[2], im[3]); o.z = pk2(im[4], im[5]); o.w = pk2(im[6], im[7]);
            *(GAS v4u*)(Pm + (size_t)(dir * 128 + 64 + p) * 1024 + s * 16 + hc * 8) = o; }
        for (int it = tid; it < 512 * 8; it += 512) { const int oc = it & 7, rl = it >> 3, t = rl >> 3, c = 8 * ch + (rl & 7), row = t * 16 + c; float re[8], im[8];
#pragma unroll
            for (int j = 0; j < 8; ++j) { const int p = oc * 8 + j; const f32x2 w = PW[p * 65 + (dir == 0 ? t + 1 : 64 - t)], cc = CC[c * 64 + p]; re[j] = cc.x * w.x - cc.y * w.y; im[j] = -(cc.x * w.y + cc.y * w.x); }
            v4u o; o.x = pk2(re[0], re[1]); o.y = pk2(re[2], re[3]); o.z = pk2(re[4], re[5]); o.w = pk2(re[6], re[7]);
            *(GAS v4u*)(BtD + (size_t)row * UPITCH + 1024 + dir * 128 + oc * 8) = o;
            o.x = pk2(im[0], im[1]); o.y = pk2(im[2], im[3]); o.z = pk2(im[4], im[5]); o.w = pk2(im[6], im[7]);
            *(GAS v4u*)(BtD + (size_t)row * UPITCH + 1024 + dir * 128 + 64 + oc * 8) = o; }
        __syncthreads();
    }
    if (quarter == 0) KM[63 * 128 + pairl] = (bf16)f2bf(k0sum + (kc == kcp ? dd[g * 16 + kc] : 0.f));
    __syncthreads();
    for (int it = tid; it < 512 * 128; it += 512) { const int q = it & 127, rl = it >> 7, t = rl >> 3, cl = rl & 7, s = q >> 1, hc = q & 1;
        const v4u o = *(const LAS v4u*)(KM + (size_t)(t - s + 63) * 128 + cl * 16 + hc * 8);
        *(GAS v4u*)(BtD + (size_t)(t * 16 + 8 * ch + cl) * UPITCH + s * 16 + hc * 8) = o; }
    __syncthreads();
}
__device__ __forceinline__ unsigned wq_issue(Frame& F, gu32* head, int chunk) { return F.tid == 0 ? __hip_atomic_fetch_add(head, (unsigned)chunk, RLX_AGENT) : 0u; }
__device__ __forceinline__ int wq_take(Frame& F, unsigned ticket) {
    __syncthreads();
    if (F.tid == 0) F.MISC[4] = ticket;
    __syncthreads();
    return (int)F.MISC[4];
}
__device__ __forceinline__ void grp_sync(Frame& F, gu32* cnt, unsigned target) {
    VM_WAIT(); __syncthreads();
    if (F.tid == 0) { __hip_atomic_fetch_add(cnt, 1u, RLX_AGENT); unsigned sp = 0;
        while (__hip_atomic_load(cnt, RLX_AGENT) < target) { __builtin_amdgcn_s_sleep(1); if (++sp > (1u << 22)) break; }
        __builtin_amdgcn_fence(__ATOMIC_ACQUIRE, "agent"); VM_WAIT(); }
    __syncthreads();
}
__device__ __forceinline__ int wg_dequeue(Frame& F, gu32* head, int chunk) {
    __syncthreads();
    if (F.tid == 0) F.MISC[4] = __hip_atomic_fetch_add(head, (unsigned)chunk, RLX_AGENT);
    __syncthreads();
    return (int)F.MISC[4];
}
constexpr int KV_WG0 = 64;
constexpr int KV_ITEMS = (DM / 64) * (1024 / 32) + NMEM;
__device__ __forceinline__ void p0_prologue(Frame& F, int rep) {
    LAS float* scr = (LAS float*)(F.lds + RING_OFF + F.wave * 16384);
    if (blockIdx.x < 2 * NGRP) p0_ssm_group(F, blockIdx.x >> 1, blockIdx.x & 1);
    else if (blockIdx.x < KV_WG0 + 4) {
        const int j = blockIdx.x - KV_WG0;
        if (F.tid == 0) { unsigned sp = 0; while (__hip_atomic_load(F.ctl + CW_KVD, RLX_AGENT) < (unsigned)KV_ITEMS) { __builtin_amdgcn_s_sleep(8); if (++sp > (1u << 22)) break; }
            __builtin_amdgcn_fence(__ATOMIC_ACQUIRE, "agent"); VM_WAIT(); }
        __syncthreads();
        pg8::Gemm g{(const pg8::bf16_t*)(F.ws + WS_MEMN), (const pg8::bf16_t*)(F.ws + WS_WKV), DM, DM, DM}; pg8::OneUnit S; S.u = pg8::Unit{0, j, 0, j};
        pg8::EpiBf16<0> E{(pg8::bf16_t*)(F.ws + WS_KVM), 1024};
        pg8::gemm_phase<pg8::EpiBf16<0>, pg8::OneUnit, true, true>(F.lds + RING_OFF, g, S, E);
    }
    constexpr int I_KV = (DM / 64) * (1024 / 32), I_IN = (DM / 64) * (INW / 32), I_OUT = (DM / 64) * (DM / 32), I_F1 = (DM / 64) * (DFF / 32), I_F2 = (DFF / 64) * (DM / 32), I_GLU = (512 / 64) * (512 / 32);
    constexpr int NTR = KV_ITEMS + I_IN + I_OUT + I_F1 + I_F2 + I_GLU, NITEMS = NTR + SEQ, CHUNK = 8;
    static_assert(KV_ITEMS % CHUNK == 0, "KV items fill whole chunks");
    for (unsigned tk = wq_issue(F, F.ctl + CW_Q0, CHUNK);;) {
        const int base = wq_take(F, tk); if (base >= NITEMS) break; tk = wq_issue(F, F.ctl + CW_Q0, CHUNK);
        for (int it = base + F.wave; it < base + CHUNK && it < NITEMS; it += NWAVES) {
            int r = it;
            if (r >= NTR) { const int m = r - NTR; rms_row_to_bf16(F.lane, F.in[0] + (size_t)m * DM, (bf16*)(F.ws + WS_XN) + (size_t)m * DM); continue; }
            if (r < I_KV) { p0_transpose_item(F.in[16], DM, 1024, (bf16*)(F.ws + WS_WKV), F.in[15], scr, r, F.lane); continue; } r -= I_KV;
            if (r < NMEM) { rms_row_to_bf16(F.lane, F.in[1] + (size_t)r * DM, (bf16*)(F.ws + WS_MEMN) + (size_t)r * DM); continue; } r -= NMEM;
            if (r < I_IN) { p0_transpose_item(F.in[3], DM, INW, (bf16*)(F.ws + WS_WIN), F.in[2], scr, r, F.lane); continue; } r -= I_IN;
            if (r < I_OUT) { const int kb = r / (DM / 32), k0 = kb * 64;
                const float* gain = k0 < 1024 ? F.in[17] : (k0 < 1536 ? F.in[18] - 1024 : F.in[19] - 1536);
                p0_transpose_item(F.in[20], DM, DM, (bf16*)(F.ws + WS_WOUT), gain, scr, r, F.lane, 1); continue; } r -= I_OUT;
            if (r < I_F1) { p0_transpose_item(F.in[23], DM, DFF, (bf16*)(F.ws + WS_WFF1), F.in[22], scr, r, F.lane); continue; } r -= I_F1;
            if (r < I_F2) { p0_transpose_item(F.in[24], DFF, DM, (bf16*)(F.ws + WS_W2T), nullptr, scr, r, F.lane); continue; } r -= I_F2;
            p0_transpose_item(F.in[13], 512, 512, (bf16*)(F.ws + WS_WGLU), nullptr, scr, r, F.lane);
        }
        if (base < KV_ITEMS) {
            VM_WAIT(); __syncthreads();
            if (F.tid == 0) { __builtin_amdgcn_fence(__ATOMIC_RELEASE, "agent"); VM_WAIT(); __hip_atomic_fetch_add(F.ctl + CW_KVD, (unsigned)CHUNK, RLX_AGENT); }
        }
    }
}
template <bool NA>
__device__ __forceinline__ void naive_attn_task(Frame& F, int token, int h) {
    constexpr int NKL = NA ? 2 : 4;
    const int lane = F.lane;
    const bf16* Qn = (const bf16*)(F.ws + WS_QN); const bf16* Kn = (const bf16*)(F.ws + WS_KN); const bf16* Vn = (const bf16*)(F.ws + WS_VN);
    const bf16* Qm = (const bf16*)(F.ws + WS_QM); const bf16* KV = (const bf16*)(F.ws + WS_KVM); bf16* Y = (bf16*)(F.ws + WS_Y);
    const bf16* qp = NA ? Qn + (size_t)token * 1024 + h * 128 : Qm + (size_t)token * 512 + h * 128;
    bf16x8 q[16];
#pragma unroll
    for (int i = 0; i < 16; ++i) q[i] = *(const GAS bf16x8*)(qp + 8 * i);
    const int r = token >> 6, c = token & 63;
    const int rs = min(max(r - 4, 0), 248), cs = min(max(c - 8, 0), 48);
    float sc[NKL]; float mx = -1e30f;
#pragma unroll
    for (int kk = 0; kk < NKL; ++kk) { const int kidx = lane + 64 * kk; int ktok; float bias = 0.f;
        if (NA) { const int kr = rs + (kidx >> 4), kcl = cs + (kidx & 15); ktok = kr * 64 + kcl; bias = F.in[4][h * 465 + (kr - r + 7) * 31 + (kcl - c + 15)]; } else ktok = kidx;
        const bf16* kp = NA ? Kn + (size_t)ktok * 1024 + h * 128 : KV + (size_t)ktok * 1024 + h * 128;
        float dot = 0.f;
#pragma unroll
        for (int i = 0; i < 16; ++i) { const bf16x8 kv = *(const GAS bf16x8*)(kp + 8 * i);
#pragma unroll
            for (int e = 0; e < 8; ++e) dot += __uint_as_float(((unsigned)(unsigned short)q[i][e]) << 16) * __uint_as_float(((unsigned)(unsigned short)kv[e]) << 16); }
        sc[kk] = dot * 0.08838834764831845f + bias; mx = fmaxf(mx, sc[kk]); }
    mx = wave_max(mx); float sum = 0.f;
#pragma unroll
    for (int kk = 0; kk < NKL; ++kk) { sc[kk] = __expf(sc[kk] - mx); sum += sc[kk]; }
    sum = wave_sum(sum);
    float o0 = 0.f, o1 = 0.f;
#pragma unroll
    for (int kk = 0; kk < NKL; ++kk)
        for (int src = 0; src < 64; ++src) { const float pj = __shfl(sc[kk], src); const int kidx = src + 64 * kk; int ktok;
            if (NA) ktok = (rs + (kidx >> 4)) * 64 + cs + (kidx & 15); else ktok = kidx;
            const bf16* vp = NA ? Vn + (size_t)ktok * 1024 + h * 128 : KV + (size_t)ktok * 1024 + 512 + h * 128;
            const unsigned v2 = *(const GAS unsigned*)(vp + 2 * lane); o0 += pj * bflo(v2); o1 += pj * bfhi(v2); }
    const float inv = 1.0f / sum;
    *(GAS unsigned*)(Y + (size_t)token * 2048 + (NA ? h * 128 : 1536 + h * 128) + 2 * lane) = pk2(o0 * inv, o1 * inv);
}
__device__ __forceinline__ void ssm_scan_group(Frame& F, int g) {
    typedef float f32x2 __attribute__((ext_vector_type(2)));
    if (F.tid >= 128) return;
    __builtin_amdgcn_fence(__ATOMIC_ACQUIRE, "agent");
    const int dir = F.tid >> 6, p = F.tid & 63;
    const f32x2 a = ((const GAS f32x2*)(F.ws + WS_A64))[(dir * NGRP + g) * 64 + p];
    const GAS float* Sl = (const GAS float*)(F.ws + WS_SLOC) + (size_t)g * 256 * 256 + dir * 128 + p;
    GAS bf16* Hin = (GAS bf16*)(F.ws + WS_U) + (size_t)g * 256 * UPITCH + 1024 + dir * 128 + p;
    float hr = 0.f, hi = 0.f;
    for (int i0 = 0; i0 < NCHK; i0 += 16) { float sr[16], si[16];
#pragma unroll
        for (int k = 0; k < 16; ++k) { const int n = dir == 0 ? i0 + k : NCHK - 1 - i0 - k; sr[k] = Sl[(size_t)n * 256]; si[k] = Sl[(size_t)n * 256 + 64]; }
#pragma unroll
        for (int k = 0; k < 16; ++k) { const int n = dir == 0 ? i0 + k : NCHK - 1 - i0 - k;
            Hin[(size_t)n * UPITCH] = (bf16)f2bf(hr); Hin[(size_t)n * UPITCH + 64] = (bf16)f2bf(hi);
            const float nr = a.x * hr - a.y * hi + sr[k], ni = a.x * hi + a.y * hr + si[k]; hr = nr; hi = ni; } }
}
__device__ __forceinline__ void ynorm_row(int lane, bf16* yrow) {
    GAS v4u* yr = (GAS v4u*)yrow + lane;
    v4u v[4]; float ss[4];
#pragma unroll
    for (int k = 0; k < 4; ++k) { v[k] = yr[64 * k]; float s = 0.f;
#pragma unroll
        for (int j = 0; j < 4; ++j) { const float a = bflo(v[k][j]), b = bfhi(v[k][j]); s += a * a + b * b; }
        ss[k] = s; }
    const float s_na = 1.f / sqrtf(wave_sum(ss[0] + ss[1]) * (1.f / 1024.f) + EPS), s_ssm = 1.f / sqrtf(wave_sum(ss[2]) * (1.f / 512.f) + EPS), s_mem = 1.f / sqrtf(wave_sum(ss[3]) * (1.f / 512.f) + EPS);
#pragma unroll
    for (int k = 0; k < 4; ++k) { const float sc = k < 2 ? s_na : (k == 2 ? s_ssm : s_mem); v4u o;
#pragma unroll
        for (int j = 0; j < 4; ++j) o[j] = pk2(bflo(v[k][j]) * sc, bfhi(v[k][j]) * sc);
        yr[64 * k] = o; }
}
__device__ __forceinline__ void mid_row(int lane, const float* xrow, const bf16* orow, const float* gpost, bf16* hrow, float* rs1out) {
    const GAS f32x4* xr = (const GAS f32x4*)xrow + lane; const GAS unsigned long long* orr = (const GAS unsigned long long*)orow + lane; const GAS f32x4* gr = (const GAS f32x4*)gpost + lane;
    f32x4 v[8]; float s = 0.f;
#pragma unroll
    for (int j = 0; j < 8; ++j) { const unsigned long long w = orr[64 * j]; v[j] = (f32x4){bflo((unsigned)w), bfhi((unsigned)w), bflo((unsigned)(w >> 32)), bfhi((unsigned)(w >> 32))};
        s += (v[j].x * v[j].x + v[j].y * v[j].y) + (v[j].z * v[j].z + v[j].w * v[j].w); }
    const float rs = 1.f / sqrtf(wave_sum(s) * (1.f / DM) + EPS); float s2 = 0.f;
    if (lane == 0) __hip_atomic_store(rs1out, rs, RLX_AGENT);
#pragma unroll
    for (int j = 0; j < 8; ++j) { v[j] = xr[64 * j] + v[j] * rs * gr[64 * j]; s2 += (v[j].x * v[j].x + v[j].y * v[j].y) + (v[j].z * v[j].z + v[j].w * v[j].w); }
    const float rs2 = 1.f / sqrtf(wave_sum(s2) * (1.f / DM) + EPS);
    unsigned long long* o8 = (unsigned long long*)hrow + lane;
#pragma unroll
    for (int j = 0; j < 8; ++j) __hip_atomic_store(o8 + 64 * j, (unsigned long long)pk2(v[j].x * rs2, v[j].y * rs2) | ((unsigned long long)pk2(v[j].z * rs2, v[j].w * rs2) << 32), RLX_AGENT);
}
__device__ __forceinline__ void final_row(int lane, const float* xrow, const bf16* orow, const bf16* frow, float rs1, const float* gpost, const float* gmlp, float* outrow) {
    const GAS f32x4* xr = (const GAS f32x4*)xrow + lane; const GAS unsigned long long* orr = (const GAS unsigned long long*)orow + lane; const GAS unsigned long long* frr = (const GAS unsigned long long*)frow + lane;
    const GAS f32x4* g1 = (const GAS f32x4*)gpost + lane; const GAS f32x4* g2 = (const GAS f32x4*)gmlp + lane; GAS f32x4* outr = (GAS f32x4*)outrow + lane;
    f32x4 fv[8]; float s = 0.f;
#pragma unroll
    for (int j = 0; j < 8; ++j) { const unsigned long long w = frr[64 * j]; fv[j] = (f32x4){bflo((unsigned)w), bfhi((unsigned)w), bflo((unsigned)(w >> 32)), bfhi((unsigned)(w >> 32))};
        s += (fv[j].x * fv[j].x + fv[j].y * fv[j].y) + (fv[j].z * fv[j].z + fv[j].w * fv[j].w); }
    const float rsf = 1.f / sqrtf(wave_sum(s) * (1.f / DM) + EPS);
#pragma unroll
    for (int j = 0; j < 8; ++j) { const unsigned long long w = orr[64 * j]; const f32x4 ov = (f32x4){bflo((unsigned)w), bfhi((unsigned)w), bflo((unsigned)(w >> 32)), bfhi((unsigned)(w >> 32))};
        outr[64 * j] = xr[64 * j] + ov * rs1 * g1[64 * j] + fv[j] * rsf * g2[64 * j]; }
}
__device__ __forceinline__ void bg_transpose(Frame& F, const float* W, int K, int N, bf16* WT, const float* gain, int part, int nparts) {
    LAS float* scr = (LAS float*)(F.lds + RING_OFF + F.wave * 16384);
    const int nitems = (K / 64) * (N / 32), per = (nitems + nparts - 1) / nparts, lo = part * per, hi = min(lo + per, nitems);
    for (int it = lo + F.wave; it < hi; it += NWAVES) p0_transpose_item(W, K, N, WT, gain, scr, it, F.lane);
}

__device__ __forceinline__ void glu_norm_unit(Frame& F, int rb) {
    int tid_ = threadIdx.x; asm volatile("" : "+v"(tid_));
    const int tid = tid_, lane = tid & 63, w = __builtin_amdgcn_readfirstlane(tid >> 6), fr = lane & 15, fq = lane >> 4;
    const bf16* Yg = (const bf16*)(F.ws + WS_YG) + (size_t)rb * 64 * 512; const bf16* WT = (const bf16*)(F.ws + WS_WGLU); bf16* Y = (bf16*)(F.ws + WS_Y) + (size_t)rb * 64 * 2048;
    LAS unsigned char* At = F.lds; LAS float* part = (LAS float*)(F.lds + 65536);
#pragma unroll
    for (int i = 0; i < 8; ++i) { const int idx = tid + 512 * i, row = idx >> 6, ch = idx & 63;
        const v4u v = *(const GAS v4u*)(Yg + (size_t)row * 512 + ch * 8); *(LAS v4u*)(At + row * 1024 + ((ch ^ (row & 15)) << 4)) = v; }
    __syncthreads();
    if (tid < 64) { const size_t row = (size_t)rb * 64 + tid; const GAS f32x4* pn = (const GAS f32x4*)((const float*)(F.ws + WS_SSQ) + row * 8); const f32x4 a = pn[0], b = pn[1];
        const f32x4 c = *(const GAS f32x4*)((const float*)(F.ws + WS_SSQ) + (size_t)SEQ * 8 + row * 4);
        const float s_na = 1.f / sqrtf((((a.x + a.y) + (a.z + a.w)) + ((b.x + b.y) + (b.z + b.w))) * (1.f / 1024.f) + EPS), s_mem = 1.f / sqrtf(((c.x + c.y) + (c.z + c.w)) * (1.f / 512.f) + EPS);
        typedef float f32x2 __attribute__((ext_vector_type(2)));
        __hip_atomic_store((unsigned long long*)(F.ws + WS_RT) + row, (unsigned long long)__float_as_uint(s_na / s_mem) | ((unsigned long long)__float_as_uint(s_mem) << 32), RLX_AGENT); }
    f32x4 acc[4][4];
#pragma unroll
    for (int m = 0; m < 4; ++m)
#pragma unroll
        for (int n = 0; n < 4; ++n) acc[m][n] = (f32x4){0.f, 0.f, 0.f, 0.f};
    const bf16* Bw = WT + (size_t)(64 * w + fr) * 512 + 8 * fq;
    bf16x8 bq0[4], bq1[4];
#pragma unroll
    for (int n = 0; n < 4; ++n) { bq0[n] = *(const GAS bf16x8*)(Bw + (size_t)n * 16 * 512); bq1[n] = *(const GAS bf16x8*)(Bw + (size_t)n * 16 * 512 + 32); }
#pragma unroll 1
    for (int kp = 0; kp < 8; ++kp) { bf16x8 a[4], b[4];
        { const int kc = kp * 8 + fq, kn = min(2 * kp + 2, 15);
#pragma unroll
          for (int n = 0; n < 4; ++n) { b[n] = bq0[n]; bq0[n] = *(const GAS bf16x8*)(Bw + (size_t)n * 16 * 512 + kn * 32); }
#pragma unroll
          for (int m = 0; m < 4; ++m) a[m] = *(const LAS bf16x8*)(At + (m * 16 + fr) * 1024 + ((kc ^ fr) << 4));
#pragma unroll
          for (int m = 0; m < 4; ++m)
#pragma unroll
              for (int n = 0; n < 4; ++n) acc[m][n] = __builtin_amdgcn_mfma_f32_16x16x32_bf16(b[n], a[m], acc[m][n], 0, 0, 0); }
        { const int kc = kp * 8 + 4 + fq, kn = min(2 * kp + 3, 15);
#pragma unroll
          for (int n = 0; n < 4; ++n) { b[n] = bq1[n]; bq1[n] = *(const GAS bf16x8*)(Bw + (size_t)n * 16 * 512 + kn * 32); }
#pragma unroll
          for (int m = 0; m < 4; ++m) a[m] = *(const LAS bf16x8*)(At + (m * 16 + fr) * 1024 + ((kc ^ fr) << 4));
#pragma unroll
          for (int m = 0; m < 4; ++m)
#pragma unroll
              for (int n = 0; n < 4; ++n) acc[m][n] = __builtin_amdgcn_mfma_f32_16x16x32_bf16(b[n], a[m], acc[m][n], 0, 0, 0); } }
    float ss[4];
#pragma unroll
    for (int m = 0; m < 4; ++m) { const int row = m * 16 + fr; float s = 0.f;
#pragma unroll
        for (int n = 0; n < 4; ++n) { const int col = 64 * w + n * 16 + 4 * fq; const f32x4 bb = *(const GAS f32x4*)(F.in[14] + col);
            const unsigned long long yy = *(const LAS unsigned long long*)(At + row * 1024 + (((col >> 3) ^ fr) << 4) + (col & 7) * 2);
            const float y0 = bflo((unsigned)yy), y1 = bfhi((unsigned)yy), y2 = bflo((unsigned)(yy >> 32)), y3 = bfhi((unsigned)(yy >> 32));
            f32x4 v = acc[m][n] + bb;
            v.x = y0 * __builtin_amdgcn_rcpf(1.0f + __builtin_amdgcn_exp2f(-1.4426950408889634f * v.x)); v.y = y1 * __builtin_amdgcn_rcpf(1.0f + __builtin_amdgcn_exp2f(-1.4426950408889634f * v.y));
            v.z = y2 * __builtin_amdgcn_rcpf(1.0f + __builtin_amdgcn_exp2f(-1.4426950408889634f * v.z)); v.w = y3 * __builtin_amdgcn_rcpf(1.0f + __builtin_amdgcn_exp2f(-1.4426950408889634f * v.w));
            acc[m][n] = v; s += (v.x * v.x + v.y * v.y) + (v.z * v.z + v.w * v.w); }
        s += __shfl_xor(s, 16); s += __shfl_xor(s, 32); ss[m] = s;
        if (fq == 0) part[row * 8 + w] = s; }
    __syncthreads();
#pragma unroll
    for (int m = 0; m < 4; ++m) { const int row = m * 16 + fr; const LAS f32x4* pp = (const LAS f32x4*)(part + row * 8); const f32x4 p0 = pp[0], p1 = pp[1];
        const float tot = ((p0.x + p0.y) + (p0.z + p0.w)) + ((p1.x + p1.y) + (p1.z + p1.w)); const float rs = 1.f / sqrtf(tot * (1.f / 512.f) + EPS);
#pragma unroll
        for (int n = 0; n < 4; ++n) { const int col = 64 * w + n * 16 + 4 * fq; const f32x4 v = acc[m][n] * rs;
            __hip_atomic_store((unsigned long long*)(Y + (size_t)row * 2048 + 1536 + col), (unsigned long long)pk2(v.x, v.y) | ((unsigned long long)pk2(v.z, v.w) << 32), RLX_AGENT); } }
    __syncthreads();
}

struct Args { const float* in[26]; float* out; unsigned char* ws; int ph_lo, ph_hi; };
constexpr int N_PHASES = 4;
__global__ void __launch_bounds__(NWAVES * 64, 2) mega(Args args) {
    extern __shared__ __attribute__((aligned(16))) unsigned char lds[];
    Frame F;
    F.lds = (LAS unsigned char*)lds;
    F.MISC = (volatile LAS unsigned*)(F.lds + MISC_OFF);
    F.tid = threadIdx.x; F.lane = F.tid & 63; F.wave = __builtin_amdgcn_readfirstlane(F.tid >> 6);
    F.G = gridDim.x; { const int bx = blockIdx.x; F.vcu = (F.G % 8 == 0) ? (bx % 8) * (F.G / 8) + bx / 8 : bx; }
    F.in = args.in;
    F.out = args.out; F.ws = args.ws; F.ctl = (gu32*)(args.ws + WS_CTL);
    for (int u = F.tid; u < (LDS_BYTES - LDSCTL_OFF) / 4; u += NWAVES * 64) ((LAS unsigned*)(F.lds + LDSCTL_OFF))[u] = 0u;
    __syncthreads();
    XcdBarrier bar = xcd_barrier_post((unsigned*)(F.ctl + CW_BAR), F.MISC + 8);
    const int lo = args.ph_lo, hi = args.ph_hi;
#define IN(k) (lo <= (k) && (k) < hi)
#define SEAM(k) do { if (IN(k) && IN((k) + 1)) xcd_barrier(bar); } while (0)
    unsigned char* ws = F.ws;
    const int gw = F.vcu * NWAVES + F.wave, NGW = F.G * NWAVES;
    using namespace pg8;
    for (int xb = 0; xb < PROBE_XBAR; ++xb) xcd_barrier(bar);
    if (IN(0)) { p0_prologue(F, 0); } SEAM(0);
    if (IN(1)) {
        Gemm g{(const bf16_t*)(ws + WS_XN), (const bf16_t*)(ws + WS_WIN), DM, DM, DM}; StaticOrder S; S.init(SEQ, INW, F.G, (int)blockIdx.x);
        EpiInProj E{ws, WS_QN, WS_U, WS_QM};
        gemm_phase<EpiInProj, StaticOrder, true, true>(F.lds + RING_OFF, g, S, E);
    } SEAM(1);
    if (IN(2)) {
        if (blockIdx.x < NGRP) {
            Gemm g{(const bf16_t*)(ws + WS_U), (const bf16_t*)(ws + WS_PM), 1024, UPITCH, 1024}; OneUnit S; S.u = Unit{(int)blockIdx.x, (int)blockIdx.x, (int)blockIdx.x, 0};
            EpiF32 E{(float*)(ws + WS_SLOC), 256};
            gemm_phase<EpiF32, OneUnit, true, true>(F.lds + RING_OFF, g, S, E);
            for (int sr_ = 0; sr_ < PROBE_SCAN_REP; ++sr_) ssm_scan_group(F, blockIdx.x);
            VM_WAIT(); __syncthreads();
            if (F.tid == 0) { __builtin_amdgcn_fence(__ATOMIC_RELEASE, "agent"); VM_WAIT(); __hip_atomic_store(F.ctl + CW_RDY + 64 * blockIdx.x, 1u, RLX_AGENT); }
        }
        for (unsigned tk = wq_issue(F, F.ctl + CW_Q2, 1);;) { const int uu = wq_take(F, tk); if (uu >= 512 * PROBE_NA_REP) break; const int u = uu & 511;
            const int qb = u >> 3, h = u & 7, r0 = qb * 4, kt0 = min(max(r0 - 4, 0), 248), krh = min(max(r0 - 1, 0), 248) + 7; int nt = krh - kt0 + 1; nt += nt & 1;
            tk = att::na_unit((char*)lds, (const bf16*)(ws + WS_QN) + (size_t)qb * 256 * 1024 + h * 128, (const bf16*)(ws + WS_KN) + h * 128, (const bf16*)(ws + WS_VN) + h * 128,
                         (bf16*)(ws + WS_Y) + (size_t)qb * 256 * 2048 + h * 128, nt, kt0, krh, r0, F.in[4] + h * 465, (float*)(ws + WS_SSQ) + (size_t)qb * 256 * 8 + h, (unsigned*)(F.ctl + CW_Q2)); }
        for (;;) { const int uu = wg_dequeue(F, F.ctl + CW_Q2 + 128, 1); if (uu >= 128) break;
            const int g = uu >> 2, j = uu & 3;
            if (F.tid == 0) { unsigned sp = 0; while (__hip_atomic_load(F.ctl + CW_RDY + 64 * g, RLX_AGENT) == 0u) { __builtin_amdgcn_s_sleep(8); if (++sp > (1u << 22)) break; }
                __builtin_amdgcn_fence(__ATOMIC_ACQUIRE, "agent"); VM_WAIT(); }
            __syncthreads();
            Gemm gd{(const bf16_t*)(ws + WS_U), (const bf16_t*)(ws + WS_BTD), UPITCH, UPITCH, UPITCH}; OneUnit S; S.u = Unit{g, g * 4 + j, g, j};
            EpiSsmD E{(bf16_t*)(ws + WS_YG)};
            gemm_phase<EpiSsmD, OneUnit, true, true>(F.lds + RING_OFF, gd, S, E); }
        for (unsigned tk = wq_issue(F, F.ctl + CW_Q2 + 64, 1);;) { const int uu = wq_take(F, tk); if (uu >= 256 * PROBE_MEM_REP) break; const int v = uu & 255, qb = v >> 2, h = v & 3;
            tk = att::attn_unit<false, 512>((char*)lds, (const bf16*)(ws + WS_QM) + (size_t)qb * 256 * 512 + h * 128, (const bf16*)(ws + WS_KVM) + h * 128, (const bf16*)(ws + WS_KVM) + 512 + h * 128,
                                       (bf16*)(ws + WS_Y) + (size_t)qb * 256 * 2048 + 1024 + h * 128, 4, 0, 0, nullptr, (float*)(ws + WS_SSQ) + (size_t)SEQ * 8 + (size_t)qb * 256 * 4 + h, 4, (unsigned*)(F.ctl + CW_Q2 + 64)); }
    } SEAM(2);
    if (IN(3)) {
        const int c = (int)blockIdx.x, gidx = (c & 7) * 4 + (c >> 6), mem = (c >> 3) & 7, PA = 2 * gidx;
        gu32* gcnt = F.ctl + CW_GRP + 64 * gidx;
        glu_norm_unit(F, 8 * gidx + mem);
        grp_sync(F, gcnt, 8u);
        { Gemm g{(const bf16_t*)(ws + WS_Y), (const bf16_t*)(ws + WS_WOUT), DM, DM, DM}; TwoUnits S; S.u0 = Unit{PA, mem, PA, mem}; S.u1 = Unit{PA + 1, mem, PA + 1, mem};
          EpiOutProj E{(bf16_t*)(ws + WS_XN), DM, (const float*)(ws + WS_RT)};
          gemm_phase<EpiOutProj, TwoUnits, true, true>(F.lds + RING_OFF, g, S, E); }
        grp_sync(F, gcnt, 16u);
        for (int i = 0; i < 8; ++i) { const int m = PA * 256 + 64 * mem + 8 * F.wave + i;
            mid_row(F.lane, F.in[0] + (size_t)m * DM, (const bf16*)(ws + WS_XN) + (size_t)m * DM, F.in[21], (bf16*)(ws + WS_Y) + (size_t)m * DM, (float*)(ws + WS_RS1) + m); }
        grp_sync(F, gcnt, 24u);
        { Gemm g{(const bf16_t*)(ws + WS_Y), (const bf16_t*)(ws + WS_WFF1), DM, DM, DM}; GroupFf1Order S{PA, mem, 0, 8};
          EpiBf16<1> E{(bf16_t*)(ws + WS_HID), DFF};
          gemm_phase<EpiBf16<1>, GroupFf1Order, true, true>(F.lds + RING_OFF, g, S, E); }
        grp_sync(F, gcnt, 32u);
#pragma unroll 1
        for (int i = 0; i < 2; ++i) {
            Gemm g{(const bf16_t*)(ws + WS_HID), (const bf16_t*)(ws + WS_W2T), DFF, DFF, DFF}; OneUnit S; S.u = Unit{PA + i, mem, PA + i, mem};
            EpiFusedFinal E{F.in[0], (const bf16_t*)(ws + WS_XN), (const float*)(ws + WS_RS1), F.in[21], F.in[25], F.out, (unsigned*)(ws + WS_XS), (unsigned*)(F.ctl + CW_PAN)};
            gemm_phase<EpiFusedFinal, OneUnit, false, true>(F.lds + RING_OFF, g, S, E); }
    }
#undef IN
#undef SEAM
}

#ifndef PROBE_PREFIX
#define PROBE_PREFIX -1
#endif
#ifndef MK_N_LAUNCHES
#define MK_N_LAUNCHES 1
#endif
extern "C" void kernel_launch(void* const* d_in, const int* in_sizes, int n_in, void* d_out, int out_size, void* d_ws, size_t ws_size, hipStream_t stream) {
    static int grid = 0;
    if (grid == 0) {
        if (n_in != 26 || in_sizes[0] != SEQ * DM || out_size != SEQ * DM || ws_size < WS_END) { fprintf(stderr, "kernel_launch: unexpected shapes: n_in %d in0 %d out %d ws %zu\n", n_in, n_in > 0 ? in_sizes[0] : -1, out_size, ws_size); grid = -1; return; }
        int dev = 0, cus = 0;
        if (hipGetDevice(&dev) != hipSuccess || hipDeviceGetAttribute(&cus, hipDeviceAttributeMultiprocessorCount, dev) != hipSuccess) { grid = -1; return; }
        if (hipFuncSetAttribute((const void*)mega, hipFuncAttributeMaxDynamicSharedMemorySize, LDS_BYTES) != hipSuccess) { fprintf(stderr, "kernel_launch: hipFuncSetAttribute failed\n"); grid = -1; return; }
        grid = cus;
    }
    if (grid < 0) return;
    if (hipMemsetAsync((char*)d_ws + WS_CTL, 0, CTL_ZERO_BYTES, stream) != hipSuccess) return;
    Args a{};
    for (int i = 0; i < 26; ++i) a.in[i] = (const float*)d_in[i];
    a.out = (float*)d_out; a.ws = (unsigned char*)d_ws;
    if (PROBE_PREFIX >= 0) { a.ph_lo = 0; a.ph_hi = PROBE_PREFIX + 1; hipLaunchKernelGGL(mega, dim3(grid), dim3(NWAVES * 64), LDS_BYTES, stream, a); (void)hipMemsetAsync((char*)d_ws + WS_CTL, 0, CTL_ZERO_BYTES, stream); }
    if (MK_N_LAUNCHES == 1) { a.ph_lo = 0; a.ph_hi = N_PHASES; hipLaunchKernelGGL(mega, dim3(grid), dim3(NWAVES * 64), LDS_BYTES, stream, a); }
    else for (int p = 0; p < N_PHASES; ++p) { a.ph_lo = p; a.ph_hi = p + 1; hipLaunchKernelGGL(mega, dim3(grid), dim3(NWAVES * 64), LDS_BYTES, stream, a); }
}
```

```cpp
#include <hip/hip_runtime.h>
#include <cstdio>
#include <cstdint>
#ifndef PROBE_NA_REP
#define PROBE_NA_REP 1
#endif
#ifndef PROBE_MEM_REP
#define PROBE_MEM_REP 1
#endif
#ifndef PROBE_SCAN_REP
#define PROBE_SCAN_REP 1
#endif
#ifndef STAGGER_US
#define STAGGER_US 0
#endif
#ifndef PROBE_XBAR
#define PROBE_XBAR 0
#endif

namespace pg8 {
#define PG8_LAS __attribute__((address_space(3)))
typedef unsigned short bf16_t;
typedef short bf16x8 __attribute__((ext_vector_type(8)));
typedef float f32x4 __attribute__((ext_vector_type(4)));
typedef unsigned u32x4 __attribute__((ext_vector_type(4)));
constexpr int BM = 256, BK = 64, HALF = 128, HTB = HALF * BK * 2  , STAGE_BYTES = 8 * HTB, NXCD = 8, WGM = 8;

__host__ __device__ __forceinline__ int lds_byte(int r, int c) { const int st = (r >> 4) * 2 + (c >> 5), rr = r & 15, cc = c & 31, ob = rr * 64 + cc * 2; return st * 1024 + (ob ^ (((ob >> 9) & 1) << 5)); }
__host__ __device__ __forceinline__ void stage_rc(int b, int& R, int& C) { const int st = b / 1024, sb = b % 1024, swz = sb ^ (((sb >> 9) & 1) << 5); R = (st >> 1) * 16 + swz / 64; C = (st & 1) * 32 + (swz % 64) / 2; }
__host__ __device__ __forceinline__ int perm32(int rho) { const int n = rho >> 4, i = rho & 15; return 8 * (i >> 2) + 4 * n + (i & 3); }

struct Unit { int pm, pn, om, on; };
struct Gemm { const bf16_t* A; const bf16_t* Bt; int K, lda, ldb; int a_img; };

struct StaticOrder {
    int nM, nN, nwg, G, c;
    __host__ __device__ void init(int M, int N, int G_, int c_) { nM = M / BM; nN = N / BM; nwg = nM * nN; G = G_; c = c_; }
    __host__ __device__ bool next(int i, Unit& u) const {
        const long L = (long)i * G + c; if (L >= nwg) return false;
        int wgid = (int)L; { const int q = nwg / NXCD, r = nwg % NXCD, xcd = wgid % NXCD, off = wgid / NXCD; wgid = (xcd < r ? xcd * (q + 1) : r * (q + 1) + (xcd - r) * q) + off; }
        const int nig = WGM * nN, gid = wgid / nig, fm = gid * WGM, gsz = (nM - fm) < WGM ? (nM - fm) : WGM;
        u.pm = fm + ((wgid % nig) % gsz); u.pn = (wgid % nig) / gsz; u.om = u.pm; u.on = u.pn; return true;
    }
    __device__ __forceinline__ void a_ready(const Unit&) const {}
    __device__ __forceinline__ void done(const Unit&) const {}
};
struct BatchOrder {
    int nb, njb, G, c;
    __host__ __device__ void init(int nb_, int njb_, int G_, int c_) { nb = nb_; njb = njb_; G = G_; c = c_; }
    __host__ __device__ bool next(int i, Unit& u) const {
        const long L = (long)i * G + c; if (L >= (long)nb * njb) return false;
        const int b = (int)L / njb, j = (int)L % njb; u.pm = b; u.pn = b * njb + j; u.om = b; u.on = j; return true;
    }
    __device__ __forceinline__ void a_ready(const Unit&) const {}
    __device__ __forceinline__ void done(const Unit&) const {}
};

struct PanelOrder {
    int nM, nN, nwg, G, c;
    __host__ __device__ void init(int M, int N, int G_, int c_) { nM = M / BM; nN = N / BM; nwg = nM * nN; G = G_; c = c_; }
    __host__ __device__ bool next(int i, Unit& u) const {
        const long L = (long)i * G + c; if (L >= nwg) return false;
        int wgid = (int)L; { const int q = nwg / NXCD, r = nwg % NXCD, xcd = wgid % NXCD, off = wgid / NXCD; wgid = (xcd < r ? xcd * (q + 1) : r * (q + 1) + (xcd - r) * q) + off; }
        const int nig = WGM * nN, gid = wgid / nig, fm = gid * WGM, w = wgid % nig;
        u.pm = fm + w / nN; u.pn = w % nN; u.om = u.pm; u.on = u.pn; return true;
    }
    __device__ __forceinline__ void a_ready(const Unit&) const {}
    __device__ __forceinline__ void done(const Unit&) const {}
};
struct TwoUnits { Unit u0, u1; __host__ __device__ bool next(int i, Unit& o) const { if (i > 1) return false; o = i ? u1 : u0; return true; }
    __device__ __forceinline__ void a_ready(const Unit&) const {} __device__ __forceinline__ void done(const Unit&) const {} };
struct GroupFf1Order { int pa, mem, first, count; __host__ __device__ bool next(int i, Unit& o) const { if (i >= count) return false; const int k = first + i; o.pm = pa + (k >> 2); o.pn = 8 * (k & 3) + mem; o.om = o.pm; o.on = o.pn; return true; }
    __device__ __forceinline__ void a_ready(const Unit&) const {} __device__ __forceinline__ void done(const Unit&) const {} };
struct OneUnit { Unit u; __host__ __device__ bool next(int i, Unit& o) const { if (i) return false; o = u; return true; }
    __device__ __forceinline__ void a_ready(const Unit&) const {} __device__ __forceinline__ void done(const Unit&) const {} };
__device__ __forceinline__ unsigned cvt_pk_bf16(float lo, float hi) { unsigned r; asm volatile("v_cvt_pk_bf16_f32 %0, %1, %2" : "=v"(r) : "v"(lo), "v"(hi)); return r; }
__device__ __forceinline__ u32x4 pack8(const f32x4 v0, const f32x4 v1) { u32x4 w; w.x = cvt_pk_bf16(v0[0], v0[1]); w.y = cvt_pk_bf16(v0[2], v0[3]); w.z = cvt_pk_bf16(v1[0], v1[1]); w.w = cvt_pk_bf16(v1[2], v1[3]); return w; }
__device__ __forceinline__ float bf2f(unsigned short b) { return __uint_as_float(((unsigned)b) << 16); }

__device__ __forceinline__ void store16_wt(void* p, u32x4 v) { asm volatile("global_store_dwordx4 %0, %1, off sc1\n\ts_nop 1" :: "v"(p), "v"(v) : "memory"); }
struct EpiInProj {
    static constexpr bool PERM = true, AFTER_DRAIN = false, KSCALE = false;
    unsigned char* ws; size_t off_qkv, off_u, off_qm;
    __device__ __forceinline__ void operator()(const f32x4 (&acc)[2][2][4][2], const Unit& u, int wr, int wc, int fr, int fq) const {
        const int ct = u.on, row0 = u.om * BM + wr * 64 + fr, cin = wc * 32 + 8 * fq;
#pragma unroll
        for (int ai = 0; ai < 2; ++ai)
#pragma unroll
            for (int m = 0; m < 4; ++m) { const int row = row0 + ai * HALF + m * 16;
#pragma unroll
                for (int bj = 0; bj < 2; ++bj) { const int c = cin + bj * HALF; const u32x4 w = pack8(acc[ai][bj][m][0], acc[ai][bj][m][1]); size_t off;
                    if (ct < 12) off = off_qkv + (size_t)(ct >> 2) * (32u << 20) + ((size_t)row * 1024 + (ct & 3) * 256 + c) * 2;
                    else if (ct < 14) { const int ch = (ct - 12) * 256 + c; off = off_u + ((size_t)((ch >> 4) * 256 + (row >> 6)) * 1280 + (row & 63) * 16 + (ch & 15)) * 2; }
                    else off = off_qm + ((size_t)row * 512 + (ct - 14) * 256 + c) * 2;
                    *(u32x4*)(ws + off) = w; } }
    }
};
struct EpiF32 {
    static constexpr bool PERM = false, AFTER_DRAIN = false, KSCALE = false;
    float* C; int ldc;
    __device__ __forceinline__ void operator()(const f32x4 (&acc)[2][2][4][2], const Unit& u, int wr, int wc, int fr, int fq) const {
        const int row0 = u.om * BM + wr * 64 + fr, col0 = u.on * BM + wc * 32 + 4 * fq;
#pragma unroll
        for (int ai = 0; ai < 2; ++ai)
#pragma unroll
            for (int m = 0; m < 4; ++m) { float* rowp = C + (size_t)(row0 + ai * HALF + m * 16) * ldc + col0;
#pragma unroll
                for (int bj = 0; bj < 2; ++bj)
#pragma unroll
                    for (int n = 0; n < 2; ++n) *(f32x4*)(rowp + bj * HALF + n * 16) = acc[ai][bj][m][n]; }
    }
};
template <int ACT  > struct EpiBf16 {
    static constexpr bool PERM = true, AFTER_DRAIN = false, KSCALE = false;
    bf16_t* O; int ldc;
    __device__ __forceinline__ void operator()(const f32x4 (&acc)[2][2][4][2], const Unit& u, int wr, int wc, int fr, int fq) const {
        const int row0 = u.om * BM + wr * 64 + fr, col0 = u.on * BM + wc * 32 + 8 * fq;
#pragma unroll
        for (int ai = 0; ai < 2; ++ai)
#pragma unroll
            for (int m = 0; m < 4; ++m) { bf16_t* rowp = O + (size_t)(row0 + ai * HALF + m * 16) * ldc + col0;
#pragma unroll
                for (int bj = 0; bj < 2; ++bj) { f32x4 v0 = acc[ai][bj][m][0], v1 = acc[ai][bj][m][1];
                    if (ACT == 1) {
#pragma unroll
                        for (int j = 0; j < 4; ++j) { const float a = fmaxf(v0[j], 0.f), b = fmaxf(v1[j], 0.f); v0[j] = a * a; v1[j] = b * b; } }
                    if (ACT == 1) store16_wt(rowp + bj * HALF, pack8(v0, v1)); else *(u32x4*)(rowp + bj * HALF) = pack8(v0, v1); } }
    }
};
struct EpiFusedFinal {
    static constexpr bool PERM = false, AFTER_DRAIN = true, KSCALE = false;
    const float* x; const bf16_t* o; const float* rs1; const float* g1; const float* g2; float* out;
    unsigned* xs;
    unsigned* cnt;
    __device__ __forceinline__ void fused(f32x4 (&acc)[2][2][4][2], const Unit& u, int wr, int wc, int fr, int fq, PG8_LAS unsigned char* lds, int wid, int lane) const {
        PG8_LAS float* P = (PG8_LAS float*)(lds + 131072);
        PG8_LAS float* S = (PG8_LAS float*)(lds + 131072 + 4096);
#pragma unroll
        for (int ai = 0; ai < 2; ++ai)
#pragma unroll
            for (int m = 0; m < 4; ++m) { float s = 0.f;
#pragma unroll
                for (int bj = 0; bj < 2; ++bj)
#pragma unroll
                    for (int n = 0; n < 2; ++n) { const f32x4 v = acc[ai][bj][m][n]; s += (v[0] * v[0] + v[1] * v[1]) + (v[2] * v[2] + v[3] * v[3]); }
                s += __shfl_xor(s, 16); s += __shfl_xor(s, 32);
                if (fq == 0) P[(ai * HALF + wr * 64 + m * 16 + fr) * 4 + wc] = s; }
#pragma unroll
        for (int ai = 0; ai < 2; ++ai)
#pragma unroll
            for (int m = 0; m < 4; ++m) { const int r = ai * HALF + wr * 64 + m * 16 + fr;
#pragma unroll
                for (int bj = 0; bj < 2; ++bj)
#pragma unroll
                    for (int n = 0; n < 2; ++n) { const int ch = (bj * HALF + wc * 32 + n * 16 + 4 * fq) >> 2; const f32x4 v = acc[ai][bj][m][n];
                        *(PG8_LAS unsigned long long*)(lds + r * 512 + ((ch ^ (r & 15)) << 3)) = (unsigned long long)cvt_pk_bf16(v[0], v[1]) | ((unsigned long long)cvt_pk_bf16(v[2], v[3]) << 32); } }
        asm volatile("s_waitcnt lgkmcnt(0)" ::: "memory"); __builtin_amdgcn_s_barrier(); asm volatile("" ::: "memory");
        const int row = wid * 32 + (lane & 31);
        if (lane < 32) { const PG8_LAS f32x4* pp = (const PG8_LAS f32x4*)(P + row * 4); const f32x4 p = pp[0]; const float t = (p[0] + p[1]) + (p[2] + p[3]);
            __hip_atomic_store(xs + ((size_t)(u.pm * BM + row) * 8 + u.pn), __float_as_uint(t), __ATOMIC_RELAXED, __HIP_MEMORY_SCOPE_AGENT); }
        asm volatile("s_waitcnt vmcnt(0)" ::: "memory");
        if (lane == 0) __hip_atomic_fetch_add(cnt + 64 * u.pm, 1u, __ATOMIC_RELAXED, __HIP_MEMORY_SCOPE_AGENT);
        if (wid == 0) { unsigned sp = 0;
            while ((unsigned)__builtin_amdgcn_readfirstlane(__hip_atomic_load(cnt + 64 * u.pm, __ATOMIC_RELAXED, __HIP_MEMORY_SCOPE_AGENT)) < 64u) { __builtin_amdgcn_s_sleep(2); if (++sp > (1u << 22)) break; }
            __builtin_amdgcn_fence(__ATOMIC_ACQUIRE, "agent"); }
        asm volatile("s_waitcnt vmcnt(0) lgkmcnt(0)" ::: "memory"); __builtin_amdgcn_s_barrier(); asm volatile("" ::: "memory");
        if (lane < 32) { const unsigned* slot = xs + (size_t)(u.pm * BM + row) * 8; float tot = 0.f;
#pragma unroll
            for (int t = 0; t < 8; ++t) tot += __uint_as_float(__hip_atomic_load(slot + t, __ATOMIC_RELAXED, __HIP_MEMORY_SCOPE_AGENT));
            S[row] = 1.0f / sqrtf(tot * (1.0f / 2048.0f) + 1e-6f); }
        asm volatile("s_waitcnt lgkmcnt(0)" ::: "memory"); __builtin_amdgcn_s_barrier(); asm volatile("" ::: "memory");
        const size_t colg = (size_t)u.pn * BM + 4 * lane;
        const f32x4 ga = *(const f32x4*)(g1 + colg), gb = *(const f32x4*)(g2 + colg);
#pragma unroll 8
        for (int i = 0; i < 32; ++i) { const int r = wid * 32 + i; const size_t off = (size_t)(u.pm * BM + r) * 2048 + colg;
            const f32x4 xv = *(const f32x4*)(x + off); const unsigned long long ow = *(const unsigned long long*)(o + off);
            const unsigned long long fw = *(const PG8_LAS unsigned long long*)(lds + r * 512 + ((lane ^ (r & 15)) << 3));
            const float rsf = S[r], r1 = rs1[(size_t)(u.pm * BM + r)];
            const f32x4 ov = (f32x4){__uint_as_float((unsigned)ow << 16), __uint_as_float((unsigned)ow & 0xffff0000u), __uint_as_float((unsigned)(ow >> 32) << 16), __uint_as_float((unsigned)(ow >> 32) & 0xffff0000u)};
            const f32x4 fv = (f32x4){__uint_as_float((unsigned)fw << 16), __uint_as_float((unsigned)fw & 0xffff0000u), __uint_as_float((unsigned)(fw >> 32) << 16), __uint_as_float((unsigned)(fw >> 32) & 0xffff0000u)};
            *(f32x4*)(out + off) = xv + ov * r1 * ga + fv * rsf * gb; }
        asm volatile("s_waitcnt lgkmcnt(0)" ::: "memory"); __builtin_amdgcn_s_barrier(); asm volatile("" ::: "memory");
    }
};
struct EpiOutProj {
    static constexpr bool PERM = true, AFTER_DRAIN = false, KSCALE = true;
    bf16_t* O; int ldc; const float* rt;
    __device__ __forceinline__ void operator()(const f32x4 (&acc)[2][2][4][2], const Unit& u, int wr, int wc, int fr, int fq) const {
        const int row0 = u.om * BM + wr * 64 + fr, col0 = u.on * BM + wc * 32 + 8 * fq;
#pragma unroll
        for (int ai = 0; ai < 2; ++ai)
#pragma unroll
            for (int m = 0; m < 4; ++m) { bf16_t* rowp = O + (size_t)(row0 + ai * HALF + m * 16) * ldc + col0;
#pragma unroll
                for (int bj = 0; bj < 2; ++bj) store16_wt(rowp + bj * HALF, pack8(acc[ai][bj][m][0], acc[ai][bj][m][1])); }
    }
};
struct EpiHidden {
    static constexpr bool PERM = true, AFTER_DRAIN = false, KSCALE = false;
    unsigned char* H;
    __device__ __forceinline__ void operator()(const f32x4 (&acc)[2][2][4][2], const Unit& u, int wr, int wc, int fr, int fq) const {
        unsigned char* pan = H + (size_t)u.om * ((size_t)BM * 8192 * 2);
        const int inrow = ((fr * 64 + fq * 16) ^ (((fr >> 3) & 1) << 5));
#pragma unroll
        for (int ai = 0; ai < 2; ++ai)
#pragma unroll
            for (int m = 0; m < 4; ++m)
#pragma unroll
                for (int bj = 0; bj < 2; ++bj) { f32x4 v0 = acc[ai][bj][m][0], v1 = acc[ai][bj][m][1];
#pragma unroll
                    for (int j = 0; j < 4; ++j) { const float a = fmaxf(v0[j], 0.f), b = fmaxf(v1[j], 0.f); v0[j] = a * a; v1[j] = b * b; }
                    const int kt = u.on * 4 + 2 * bj + (wc >> 1), st = (4 * wr + m) * 2 + (wc & 1);
                    store16_wt(pan + ((size_t)kt * 2 + ai) * HTB + st * 1024 + inrow, pack8(v0, v1)); }
    }
};
__device__ __forceinline__ float gelu_tanh(float x) {
    const float z = 0.7978845608028654f * (x + 0.044715f * x * x * x);
    return x * __builtin_amdgcn_rcpf(1.0f + __builtin_amdgcn_exp2f(-2.0f * 1.4426950408889634f * z));
}
struct EpiSsmD {
    static constexpr bool PERM = true, AFTER_DRAIN = false, KSCALE = false;
    bf16_t* Yg;
    __device__ __forceinline__ void operator()(const f32x4 (&acc)[2][2][4][2], const Unit& u, int wr, int wc, int fr, int fq) const {
        const int g = u.om, n0 = wr * 64 + fr, col0 = u.on * BM + wc * 32 + 8 * fq;
#pragma unroll
        for (int ai = 0; ai < 2; ++ai)
#pragma unroll
            for (int m = 0; m < 4; ++m) { const int n = n0 + ai * HALF + m * 16;
#pragma unroll
                for (int bj = 0; bj < 2; ++bj) { const int col = col0 + bj * HALF, t = col >> 4, c = col & 15; f32x4 v0 = acc[ai][bj][m][0], v1 = acc[ai][bj][m][1];
#pragma unroll
                    for (int j = 0; j < 4; ++j) { v0[j] = gelu_tanh(v0[j]); v1[j] = gelu_tanh(v1[j]); }
                    *(u32x4*)(Yg + (size_t)(n * 64 + t) * 512 + g * 16 + c) = pack8(v0, v1); } }
    }
};
struct EpiGlu {
    static constexpr bool PERM = true, AFTER_DRAIN = false, KSCALE = false;
    const bf16_t* Yg; const float* bglu; bf16_t* Y;
    __device__ __forceinline__ void operator()(const f32x4 (&acc)[2][2][4][2], const Unit& u, int wr, int wc, int fr, int fq) const {
        const int row0 = u.om * BM + wr * 64 + fr, col0 = u.on * BM + wc * 32 + 8 * fq;
#pragma unroll
        for (int ai = 0; ai < 2; ++ai)
#pragma unroll
            for (int m = 0; m < 4; ++m) { const int row = row0 + ai * HALF + m * 16;
#pragma unroll
                for (int bj = 0; bj < 2; ++bj) { const int col = col0 + bj * HALF;
                    const u32x4 yv = *(const u32x4*)(Yg + (size_t)row * 512 + col);
                    const f32x4 b0 = *(const f32x4*)(bglu + col), b1 = *(const f32x4*)(bglu + col + 4);
                    f32x4 v0 = acc[ai][bj][m][0] + b0, v1 = acc[ai][bj][m][1] + b1;
                    float y[8]; y[0] = __uint_as_float(yv.x << 16); y[1] = __uint_as_float(yv.x & 0xffff0000u); y[2] = __uint_as_float(yv.y << 16); y[3] = __uint_as_float(yv.y & 0xffff0000u);
                    y[4] = __uint_as_float(yv.z << 16); y[5] = __uint_as_float(yv.z & 0xffff0000u); y[6] = __uint_as_float(yv.w << 16); y[7] = __uint_as_float(yv.w & 0xffff0000u);
#pragma unroll
                    for (int j = 0; j < 4; ++j) { v0[j] = y[j] * __builtin_amdgcn_rcpf(1.0f + __builtin_amdgcn_exp2f(-1.4426950408889634f * v0[j]));
                                                  v1[j] = y[4 + j] * __builtin_amdgcn_rcpf(1.0f + __builtin_amdgcn_exp2f(-1.4426950408889634f * v1[j])); }
                    *(u32x4*)(Y + (size_t)row * 2048 + 1024 + col) = pack8(v0, v1); } }
    }
};

template <class Epi, class Sched, bool ALIGN_EPI = false, bool SP2 = false>
__device__ __forceinline__ void gemm_phase(PG8_LAS unsigned char* lds, const Gemm g, const Sched& S, const Epi& E) {
    int tid_ = threadIdx.x; asm volatile("" : "+v"(tid_));
    const int tid = tid_, wid = __builtin_amdgcn_readfirstlane(tid >> 6), lane = tid & 63, wr = wid >> 2, wc = wid & 3, fr = lane & 15, fq = lane >> 4;
    const int K = g.K, nt = K / BK;
    unsigned voffA[2], voffB[2];
#pragma unroll
    for (int i = 0; i < 2; ++i) { int R, C; stage_rc(tid * 16 + i * 8192, R, C); const int Rb = Epi::PERM ? ((R & ~31) + perm32(R & 31)) : R;
        voffA[i] = g.a_img ? (unsigned)(tid * 16 + i * 8192) : (unsigned)(R * g.lda + C) * 2u; voffB[i] = (unsigned)(Rb * g.ldb + C) * 2u; }
    const size_t kstep = (size_t)(BK * 2);
    const size_t kstepA = g.a_img ? (size_t)(2 * HTB) : kstep;
    const size_t hstepA = g.a_img ? (size_t)HTB : (size_t)HALF * g.lda * 2, hstepB = (size_t)HALF * g.ldb * 2;
    const size_t tstepA = g.a_img ? (size_t)BM * g.lda * 2 : 2 * hstepA, tstepB = 2 * hstepB;
    const unsigned ldsw = (unsigned)wid * 1024u;
    const int aoff = lds_byte(wr * 64 + fr, fq * 8), boff = lds_byte(wc * 32 + fr, fq * 8);
#define PG8_SA(b, h) (((b) * 2 + (h)) * HTB)
#define PG8_SB(b, h) ((4 + (b) * 2 + (h)) * HTB)
#define PG8_STAGE(bufoff, gbase, voff) do { _Pragma("unroll") for (int _i = 0; _i < 2; ++_i) \
        __builtin_amdgcn_global_load_lds((const unsigned*)((const char*)(gbase) + (voff)[_i]), (PG8_LAS unsigned*)(lds + (bufoff) + ldsw + _i * 8192), 16, 0, 0); } while (0)
#define PG8_LDA(dst, b, h) do { _Pragma("unroll") for (int m = 0; m < 4; ++m) _Pragma("unroll") for (int k = 0; k < 2; ++k) dst[m][k] = *(const PG8_LAS bf16x8*)(lds + PG8_SA(b, h) + aoff + m * 2048 + k * 1024); } while (0)
#define PG8_LDB(dst, b, h) do { _Pragma("unroll") for (int n = 0; n < 2; ++n) _Pragma("unroll") for (int k = 0; k < 2; ++k) dst[n][k] = *(const PG8_LAS bf16x8*)(lds + PG8_SB(b, h) + boff + n * 2048 + k * 1024); } while (0)
#define PG8_MMA(ai, bj, At, Bt) do { __builtin_amdgcn_s_setprio(1); _Pragma("unroll") for (int m = 0; m < 4; ++m) _Pragma("unroll") for (int n = 0; n < 2; ++n) _Pragma("unroll") for (int k = 0; k < 2; ++k) \
        acc[ai][bj][m][n] = __builtin_amdgcn_mfma_f32_16x16x32_bf16(Bt[n][k], At[m][k], acc[ai][bj][m][n], 0, 0, 0); __builtin_amdgcn_s_setprio(0); } while (0)
#define PG8_WAIT_V(n) asm volatile("s_waitcnt vmcnt(" #n ")" ::: "memory")
#define PG8_WAIT_L(n) asm volatile("s_waitcnt lgkmcnt(" #n ")" ::: "memory")
#define PG8_BAR __builtin_amdgcn_s_barrier()
#define PG8_SCHED __builtin_amdgcn_sched_barrier(0)
    Unit cur, nxt; int ui = 0;
    if (!S.next(0, cur)) return;
    if constexpr (Epi::KSCALE) {
        PG8_LAS float* xt = (PG8_LAS float*)(lds + STAGE_BYTES);
        xt[tid] = E.rt[(size_t)cur.pm * 512 + tid];
        Unit u1; if (S.next(1, u1)) xt[512 + tid] = E.rt[(size_t)u1.pm * 512 + tid];
    }
    f32x4 acc[2][2][4][2];
#pragma unroll
    for (int a = 0; a < 2; ++a)
#pragma unroll
        for (int b = 0; b < 2; ++b)
#pragma unroll
            for (int m = 0; m < 4; ++m)
#pragma unroll
                for (int n = 0; n < 2; ++n) acc[a][b][m][n] = (f32x4){0.f, 0.f, 0.f, 0.f};
    bf16x8 At[4][2], B0[2][2], B1[2][2];
    const char* cA = (const char*)g.A + (size_t)cur.pm * tstepA; const char* cB = (const char*)g.Bt + (size_t)cur.pn * tstepB;
    S.a_ready(cur);
    if constexpr (SP2) {
        PG8_STAGE(PG8_SB(0, 0), cB, voffB); PG8_STAGE(PG8_SB(0, 1), cB + hstepB, voffB); PG8_STAGE(PG8_SA(0, 0), cA, voffA); PG8_STAGE(PG8_SA(0, 1), cA + hstepA, voffA);
        if (wr == 1) PG8_BAR;
        PG8_WAIT_V(2); PG8_BAR;
        PG8_STAGE(PG8_SB(1, 0), cB + kstep, voffB); PG8_STAGE(PG8_SA(1, 0), cA + kstepA, voffA); PG8_STAGE(PG8_SB(1, 1), cB + hstepB + kstep, voffB);
        PG8_WAIT_V(6); PG8_BAR;
    } else {
        PG8_STAGE(PG8_SB(0, 0), cB, voffB); PG8_STAGE(PG8_SA(0, 0), cA, voffA); PG8_STAGE(PG8_SB(0, 1), cB + hstepB, voffB); PG8_STAGE(PG8_SA(0, 1), cA + hstepA, voffA);
        if (wr == 1) PG8_BAR;
        PG8_WAIT_V(4); PG8_BAR;
        PG8_STAGE(PG8_SB(1, 0), cB + kstep, voffB); PG8_STAGE(PG8_SA(1, 0), cA + kstepA, voffA); PG8_STAGE(PG8_SB(1, 1), cB + hstepB + kstep, voffB);
        PG8_WAIT_V(6); PG8_BAR;
    }
    for (;;) {
        const bool has_next = S.next(ui + 1, nxt);
        const char* nA = has_next ? (const char*)g.A + (size_t)nxt.pm * tstepA : cA; const char* nB = has_next ? (const char*)g.Bt + (size_t)nxt.pn * tstepB : cB;
        for (int t = 0; t < nt; t += 2) {
            if constexpr (Epi::KSCALE) { if (t == 16 || t == 24) {
                const PG8_LAS float* xt = (const PG8_LAS float*)(lds + STAGE_BYTES) + (ui & 1) * 512 + (t == 24 ? 1 : 0) + (wr * 64 + fr) * 2;
#pragma unroll
                for (int ai = 0; ai < 2; ++ai)
#pragma unroll
                    for (int m = 0; m < 4; ++m) { const float f = xt[(ai * HALF + m * 16) * 2];
#pragma unroll
                        for (int bj = 0; bj < 2; ++bj)
#pragma unroll
                            for (int n = 0; n < 2; ++n) acc[ai][bj][m][n] *= f; } } }
            const bool last = (t == nt - 2);
            const char* a1 = cA + (size_t)(t + 1) * kstepA;
            const char* a2 = last ? nA : cA + (size_t)(t + 2) * kstepA; const char* b2 = last ? nB : cB + (size_t)(t + 2) * kstep;
            const char* a3 = a2 + kstepA; const char* b3 = b2 + kstep;
            if (last && has_next) S.a_ready(nxt);
            if constexpr (SP2) {
            PG8_LDB(B0, 0, 0); PG8_LDB(B1, 0, 1); PG8_SCHED; PG8_LDA(At, 0, 0); PG8_STAGE(PG8_SA(1, 1), a1 + hstepA, voffA);
            PG8_WAIT_V(8); PG8_WAIT_L(0); PG8_BAR; PG8_MMA(0, 0, At, B0); PG8_MMA(0, 1, At, B1); PG8_BAR; PG8_SCHED;
            PG8_LDA(At, 0, 1); PG8_STAGE(PG8_SB(0, 0), b2, voffB); PG8_STAGE(PG8_SB(0, 1), b2 + hstepB, voffB); PG8_STAGE(PG8_SA(0, 0), a2, voffA);
            PG8_WAIT_V(8); PG8_WAIT_L(0); PG8_BAR; PG8_MMA(1, 0, At, B0); PG8_MMA(1, 1, At, B1); PG8_BAR; PG8_SCHED;
            PG8_LDB(B0, 1, 0); PG8_LDB(B1, 1, 1); PG8_SCHED; PG8_LDA(At, 1, 0); PG8_STAGE(PG8_SA(0, 1), a2 + hstepA, voffA);
            PG8_WAIT_V(8); PG8_WAIT_L(0); PG8_BAR; PG8_MMA(0, 0, At, B0); PG8_MMA(0, 1, At, B1); PG8_BAR; PG8_SCHED;
            PG8_LDA(At, 1, 1); PG8_STAGE(PG8_SB(1, 0), b3, voffB); PG8_STAGE(PG8_SB(1, 1), b3 + hstepB, voffB); PG8_STAGE(PG8_SA(1, 0), a3, voffA);
            PG8_WAIT_V(8); PG8_WAIT_L(0); PG8_BAR; PG8_MMA(1, 0, At, B0); PG8_MMA(1, 1, At, B1); PG8_BAR; PG8_SCHED;
            } else {
            PG8_LDB(B0, 0, 0); PG8_SCHED; PG8_LDA(At, 0, 0); PG8_STAGE(PG8_SA(1, 1), a1 + hstepA, voffA);
            PG8_WAIT_L(8); PG8_BAR; PG8_WAIT_L(0); PG8_MMA(0, 0, At, B0); PG8_BAR; PG8_SCHED;
            PG8_LDB(B1, 0, 1); PG8_STAGE(PG8_SB(0, 0), b2, voffB);
            PG8_BAR; PG8_WAIT_L(0); PG8_MMA(0, 1, At, B1); PG8_BAR;
            PG8_LDA(At, 0, 1); PG8_STAGE(PG8_SA(0, 0), a2, voffA);
            PG8_BAR; PG8_WAIT_L(0); PG8_MMA(1, 0, At, B0); PG8_BAR; PG8_SCHED;
            PG8_STAGE(PG8_SB(0, 1), b2 + hstepB, voffB);
            PG8_WAIT_V(6); PG8_BAR; PG8_MMA(1, 1, At, B1); PG8_BAR;
            PG8_LDB(B0, 1, 0); PG8_SCHED; PG8_LDA(At, 1, 0); PG8_STAGE(PG8_SA(0, 1), a2 + hstepA, voffA);
            PG8_WAIT_L(8); PG8_BAR; PG8_WAIT_L(0); PG8_MMA(0, 0, At, B0); PG8_BAR; PG8_SCHED;
            PG8_LDB(B1, 1, 1); PG8_STAGE(PG8_SB(1, 0), b3, voffB);
            PG8_BAR; PG8_WAIT_L(0); PG8_MMA(0, 1, At, B1); PG8_BAR;
            PG8_LDA(At, 1, 1); PG8_STAGE(PG8_SA(1, 0), a3, voffA);
            PG8_BAR; PG8_WAIT_L(0); PG8_MMA(1, 0, At, B0); PG8_BAR; PG8_SCHED;
            PG8_STAGE(PG8_SB(1, 1), b3 + hstepB, voffB);
            PG8_WAIT_V(6); PG8_BAR; PG8_MMA(1, 1, At, B1); PG8_BAR;
            }
        }
        if constexpr (ALIGN_EPI) { if (wr == 0) PG8_BAR; }
        if constexpr (!Epi::AFTER_DRAIN) { E(acc, cur, wr, wc, fr, fq); S.done(cur); if constexpr (Epi::KSCALE) { Unit u2; if (S.next(ui + 2, u2)) ((PG8_LAS float*)(lds + STAGE_BYTES))[(ui & 1) * 512 + tid] = E.rt[(size_t)u2.pm * 512 + tid]; } }
        if (!has_next) break;
#pragma unroll
        for (int a = 0; a < 2; ++a)
#pragma unroll
            for (int b = 0; b < 2; ++b)
#pragma unroll
                for (int m = 0; m < 4; ++m)
#pragma unroll
                    for (int n = 0; n < 2; ++n) acc[a][b][m][n] = (f32x4){0.f, 0.f, 0.f, 0.f};
        cur = nxt; cA = nA; cB = nB; ++ui;
        if constexpr (ALIGN_EPI) { if (wr == 1) PG8_BAR; }
    }
    PG8_WAIT_V(0);
    if constexpr (!ALIGN_EPI) { if (wr == 0) PG8_BAR; }
    PG8_BAR;
    if constexpr (Epi::AFTER_DRAIN) { E.fused(acc, cur, wr, wc, fr, fq, lds, wid, lane); S.done(cur); }
#undef PG8_SA
#undef PG8_SB
#undef PG8_STAGE
#undef PG8_LDA
#undef PG8_LDB
#undef PG8_MMA
#undef PG8_WAIT_V
#undef PG8_WAIT_L
#undef PG8_BAR
#undef PG8_SCHED
}
}

constexpr int NWAVES = 8;
constexpr int SEQ = 16384, DM = 2048, INW = 4096, DFF = 8192, NMEM = 256;
constexpr int NAW = 1024, SSMW = 512, MEMW = 512, NGRP = 32, NST = 64, NCHK = 256  , UPITCH = 1280;
constexpr float EPS = 1e-6f;
constexpr size_t MiB = 1u << 20;
constexpr size_t WS_CTL = 0, CTL_ZERO_BYTES = 1 * MiB;
constexpr size_t WS_W2T = 1 * MiB;
constexpr size_t WS_HID = 33 * MiB;
constexpr size_t WS_QN = 33 * MiB, WS_KN = 65 * MiB, WS_VN = 97 * MiB;
constexpr size_t WS_QM = 129 * MiB;
constexpr size_t WS_U = 145 * MiB;
constexpr size_t WS_BTD = 165 * MiB;
constexpr size_t WS_PM = 245 * MiB;
constexpr size_t WS_SLOC = 261 * MiB;
constexpr size_t WS_YG = 490 * MiB;
constexpr size_t WS_KVM = 285 * MiB;
constexpr size_t WS_MEMN = 484 * MiB;
constexpr size_t WS_WIN = 289 * MiB;
constexpr size_t WS_WOUT = 305 * MiB;
constexpr size_t WS_WFF1 = 313 * MiB;
constexpr size_t WS_WGLU = 345 * MiB;
constexpr size_t WS_WKV = 346 * MiB;
constexpr size_t WS_XN = 350 * MiB;
constexpr size_t WS_Y = 414 * MiB;
constexpr size_t WS_A64 = 483 * MiB;
constexpr size_t WS_XS = 487 * MiB;
constexpr size_t WS_SSQ = 488 * MiB;
constexpr size_t WS_RT = 489 * MiB;
constexpr size_t WS_RS1 = 486 * MiB;
constexpr size_t WS_END = 512 * MiB;
constexpr int CW_TMO = 0, CW_BAR = 4096, CW_Q0 = 8192, CW_Q2 = 8448, CW_KVD = 8320, CW_RDY = 12288, CW_PAN = 16384, CW_GRP = 24576;

constexpr int RING_OFF = 0, RING_BYTES = 131072, XTAB_OFF = RING_BYTES  ;
constexpr int LDSCTL_OFF = RING_BYTES + 8192, MISC_OFF = LDSCTL_OFF + 320;
constexpr int LDS_BYTES = 163840;

#define GAS __attribute__((address_space(1)))
#define LAS __attribute__((address_space(3)))
typedef unsigned short bf16;
typedef unsigned v4u __attribute__((ext_vector_type(4)));
typedef float f32x4 __attribute__((ext_vector_type(4)));
typedef short bf16x8 __attribute__((ext_vector_type(8)));
typedef GAS unsigned gu32;
#define RLX_AGENT __ATOMIC_RELAXED, __HIP_MEMORY_SCOPE_AGENT
#define LDS_WAIT() asm volatile("s_waitcnt lgkmcnt(0)" ::: "memory")
#define VM_WAIT() asm volatile("s_waitcnt vmcnt(0)" ::: "memory")
__device__ __forceinline__ unsigned f2bf(float f) { unsigned u = __builtin_bit_cast(unsigned, f); return (u + 0x7fffu + ((u >> 16) & 1u)) >> 16; }
__device__ __forceinline__ unsigned pk2(float lo, float hi) { return f2bf(lo) | (f2bf(hi) << 16); }
__device__ __forceinline__ float bflo(unsigned w) { return __uint_as_float(w << 16); }
__device__ __forceinline__ float bfhi(unsigned w) { return __uint_as_float(w & 0xffff0000u); }

#define XB_TMO      128
#define XB_XCNT(j)  (256  + 64 * (j))
#define XB_XSUB(j)  (1280 + 64 * (j))
#define XB_XGEN(j)  (2304 + 64 * (j))
#define XB_TOP      3328
#define XB_TOPGEN   3392
#define XCD_BAR_WORDS 3456
#define XB_SPIN_CAP (1u << 18)

__device__ __forceinline__ unsigned xb_ld(unsigned* p)              { return __hip_atomic_load(p, __ATOMIC_RELAXED, __HIP_MEMORY_SCOPE_AGENT); }
__device__ __forceinline__ unsigned xb_add(unsigned* p, unsigned v) { return __hip_atomic_fetch_add(p, v, __ATOMIC_RELAXED, __HIP_MEMORY_SCOPE_AGENT); }
__device__ __forceinline__ unsigned xb_xcc_id() { return (unsigned)__builtin_amdgcn_s_getreg((3 << 11) | 20) & 0xFu; }
#define XB_SPIN(cond, bar) do { unsigned _sp = 0; while (cond) { __builtin_amdgcn_s_sleep(1); \
    if ((++_sp & 255u) == 0u) { if (xb_ld(&(bar)[XB_TMO])) break; if (_sp > XB_SPIN_CAP) { atomicAdd(&(bar)[XB_TMO], 1u); break; } } } } while (0)

struct XcdBarrier {
    unsigned* bar; unsigned x;
    volatile LAS unsigned* st;
};

__device__ __forceinline__ XcdBarrier xcd_barrier_post(unsigned* bar, volatile LAS unsigned* st) {
    XcdBarrier b; b.bar = bar; b.x = xb_xcc_id(); b.st = st;
    if (threadIdx.x == 0) (void)xb_add(&bar[XB_XCNT(b.x)], 1u);
    return b;
}
__device__ __forceinline__ void xcd_barrier_complete(unsigned* bar, unsigned x, unsigned& nloc, unsigned& nx) {
    const unsigned G = gridDim.x * gridDim.y * gridDim.z;
    unsigned sum, cnt, mine, sp = 0u;
    for (;;) {
        sum = 0u; cnt = 0u; mine = 0u;
#pragma unroll
        for (unsigned j = 0; j < 16; ++j) { const unsigned c = xb_ld(&bar[XB_XCNT(j)]); sum += c; cnt += (c > 0u) ? 1u : 0u; mine = (j == x) ? c : mine; }
        if (sum == G) break;
        __builtin_amdgcn_s_sleep(1);
        if ((++sp & 255u) == 0u) { if (xb_ld(&bar[XB_TMO])) break; if (sp > XB_SPIN_CAP) { atomicAdd(&bar[XB_TMO], 1u); break; } }
    }
    nloc = mine > 0u ? mine : 1u; nx = cnt > 0u ? cnt : 1u;
}

__device__ __forceinline__ void xcd_barrier(const XcdBarrier& b) {
    asm volatile("s_waitcnt vmcnt(0)" ::: "memory");
    __syncthreads();
    if (threadIdx.x == 0) {
        unsigned* bar = b.bar;
        __builtin_amdgcn_s_waitcnt(0);
        unsigned nloc = b.st[0], nx = b.st[1];
        if (nloc == 0u) { xcd_barrier_complete(bar, b.x, nloc, nx); b.st[0] = nloc; b.st[1] = nx; }
        const unsigned old = xb_add(&bar[XB_XSUB(b.x)], 1u);
        const unsigned gen = old / nloc;
        if (old + 1u == (gen + 1u) * nloc) {
            __builtin_amdgcn_fence(__ATOMIC_RELEASE, "agent");
            asm volatile("s_waitcnt vmcnt(0)" ::: "memory");
            const unsigned og = xb_add(&bar[XB_TOP], 1u);
            const unsigned tg = og / nx;
            if (og + 1u == (tg + 1u) * nx) xb_add(&bar[XB_TOPGEN], 1u);
            else XB_SPIN(xb_ld(&bar[XB_TOPGEN]) == tg, bar);
            __builtin_amdgcn_fence(__ATOMIC_ACQUIRE, "agent");
            xb_add(&bar[XB_XGEN(b.x)], 1u);
            asm volatile("s_waitcnt vmcnt(0)" ::: "memory");
        } else {
            XB_SPIN(xb_ld(&bar[XB_XGEN(b.x)]) == gen, bar);
            __builtin_amdgcn_fence(__ATOMIC_ACQUIRE, "agent");
            asm volatile("s_waitcnt vmcnt(0)" ::: "memory");
        }
    }
    __syncthreads();
}

namespace att {
using bf16x8 = __attribute__((ext_vector_type(8))) short;
using s16x4  = __attribute__((ext_vector_type(4))) short;
using f32x16 = __attribute__((ext_vector_type(16))) float;
using u32x4  = __attribute__((ext_vector_type(4))) unsigned;
typedef unsigned short bf16;
constexpr int   D = 128, NW = 8, QBLK = 32, KVBLK = 64;
constexpr float SCALE = 0.088388347648318440f;
constexpr float THR = 8.f;
constexpr int SHM_V = KVBLK * D * 2, SHM_K = KVBLK * D * 2;
constexpr int OFF_K = 2 * SHM_V, OFF_WS = 2 * SHM_V + 2 * SHM_K, OFF_TAB = OFF_WS + NW * 64 * 4, ATT_LDS_BYTES = OFF_TAB + (864 + 576) * 4;
#define KSWZ(row, colB) ((row) * 256 + ((colB) ^ (((row) & 7) << 4)))
#define SBAR() __builtin_amdgcn_sched_barrier(0)
__device__ __forceinline__ int crow(int r, int hi) { return (r & 3) + 8 * (r >> 2) + 4 * hi; }
__device__ __forceinline__ unsigned cvtpk(float lo, float hi) { unsigned r; asm volatile("v_cvt_pk_bf16_f32 %0, %1, %2" : "=v"(r) : "v"(lo), "v"(hi)); return r; }
__device__ __forceinline__ void partialSM(f32x16& p0, f32x16& p1, float& m_reg, float& mn, float& alpha) {
  constexpr float C = SCALE * 1.4426950408889634f;
  float pmax = p0[0]; for (int r = 1; r < 16; ++r) pmax = fmaxf(pmax, p0[r]); for (int r = 0; r < 16; ++r) pmax = fmaxf(pmax, p1[r]);
  { auto rr = __builtin_amdgcn_permlane32_swap(__float_as_uint(pmax), __float_as_uint(pmax), false, false);
    pmax = fmaxf(__uint_as_float(rr[0]), __uint_as_float(rr[1])); }
  if (__builtin_expect(__all(pmax - m_reg <= THR / SCALE), 1)) { mn = m_reg; alpha = 1.f; }
  else { mn = fmaxf(m_reg, pmax); alpha = __builtin_amdgcn_exp2f((m_reg - mn) * C); m_reg = mn; }
  float mnC = -mn * C;
  for (int r = 0; r < 16; ++r) p0[r] = fmaf(p0[r], C, mnC); for (int r = 0; r < 16; ++r) p1[r] = fmaf(p1[r], C, mnC);
  for (int r = 0; r < 16; ++r) p0[r] = __builtin_amdgcn_exp2f(p0[r]);
}
__device__ __forceinline__ void finishSM(f32x16& p0, f32x16& p1, float alpha, float& l_reg, bf16x8& pa0, bf16x8& pa1, bf16x8& pa2, bf16x8& pa3) {
  for (int r = 0; r < 16; ++r) p1[r] = __builtin_amdgcn_exp2f(p1[r]);
  float ps = 0; for (int r = 0; r < 16; ++r) ps += p0[r]; for (int r = 0; r < 16; ++r) ps += p1[r];
  { auto rr = __builtin_amdgcn_permlane32_swap(__float_as_uint(ps), __float_as_uint(ps), false, false);
    ps = __uint_as_float(rr[0]) + __uint_as_float(rr[1]); }
  l_reg = l_reg * alpha + ps;
#define PK4(P, BASE, OUT) do { unsigned a0 = cvtpk(P[BASE + 0], P[BASE + 1]), a1 = cvtpk(P[BASE + 2], P[BASE + 3]);   \
    unsigned b0 = cvtpk(P[BASE + 4], P[BASE + 5]), b1 = cvtpk(P[BASE + 6], P[BASE + 7]);                              \
    auto r0 = __builtin_amdgcn_permlane32_swap(a0, b0, false, false); auto r1 = __builtin_amdgcn_permlane32_swap(a1, b1, false, false); \
    u32x4 w = {r0[0], r1[0], r0[1], r1[1]}; OUT = *reinterpret_cast<bf16x8*>(&w); } while (0)
  PK4(p0, 0, pa0); PK4(p0, 8, pa1); PK4(p1, 0, pa2); PK4(p1, 8, pa3);
#undef PK4
}
__device__ __forceinline__ void qkt(f32x16& p0, f32x16& p1, const bf16* Ks, const bf16x8* qr, int r32, int hi) {
  p0 = f32x16{}; p1 = f32x16{};
  for (int d0 = 0; d0 < 8; ++d0) { int cb = (d0 * 16 + hi * 8) * 2;
    bf16x8 b0 = *reinterpret_cast<const bf16x8*>((const char*)Ks + KSWZ(r32, cb));
    bf16x8 b1 = *reinterpret_cast<const bf16x8*>((const char*)Ks + KSWZ(32 + r32, cb));
    p0 = __builtin_amdgcn_mfma_f32_32x32x16_bf16(b0, qr[d0], p0, 0, 0, 0);
    p1 = __builtin_amdgcn_mfma_f32_32x32x16_bf16(b1, qr[d0], p1, 0, 0, 0); }
}
__device__ __forceinline__ int v_st(int k, int c) { const int kk = (k & ~0xC) | ((k & 4) << 1) | ((k & 8) >> 1); return ((kk >> 3) * 4 + (c >> 5)) * 512 + ((kk & 7) * 32 + (c & 31)) * 2; }
__device__ __forceinline__ int v_rd_base(int lane) { return ((lane & 3) << 3) | (((lane >> 2) & 3) << 6) | (((lane >> 4) & 1) << 5) | (((lane >> 5) & 1) << 8); }
constexpr int v_rd_off(int d0, int ks, int half) { return d0 * 512 + ks * 4096 + half * 2048; }
template <int OFF> __device__ __forceinline__ s16x4 tr_read(int vb) {
  s16x4 r; asm volatile("ds_read_b64_tr_b16 %0, %1 offset:%2" : "=&v"(r) : "v"(vb), "i"(OFF) : "memory"); return r;
}
template <int D0> __device__ __forceinline__ void pv_one(f32x16& od, int vb, bf16x8 pa0, bf16x8 pa1, bf16x8 pa2, bf16x8 pa3) {
  const s16x4 l0 = tr_read<v_rd_off(D0, 0, 0)>(vb), h0 = tr_read<v_rd_off(D0, 0, 1)>(vb), l1 = tr_read<v_rd_off(D0, 1, 0)>(vb), h1 = tr_read<v_rd_off(D0, 1, 1)>(vb);
  const s16x4 l2 = tr_read<v_rd_off(D0, 2, 0)>(vb), h2 = tr_read<v_rd_off(D0, 2, 1)>(vb), l3 = tr_read<v_rd_off(D0, 3, 0)>(vb), h3 = tr_read<v_rd_off(D0, 3, 1)>(vb);
  asm volatile("s_waitcnt lgkmcnt(0)" ::: "memory"); SBAR();
#define PK(L, H) (bf16x8){L[0], L[1], L[2], L[3], H[0], H[1], H[2], H[3]}
  od = __builtin_amdgcn_mfma_f32_32x32x16_bf16(pa0, PK(l0, h0), od, 0, 0, 0);
  od = __builtin_amdgcn_mfma_f32_32x32x16_bf16(pa1, PK(l1, h1), od, 0, 0, 0);
  od = __builtin_amdgcn_mfma_f32_32x32x16_bf16(pa2, PK(l2, h2), od, 0, 0, 0);
  od = __builtin_amdgcn_mfma_f32_32x32x16_bf16(pa3, PK(l3, h3), od, 0, 0, 0);
#undef PK
}
__device__ __forceinline__ void pv_d0(f32x16* o, int vb, bf16x8 pa0, bf16x8 pa1, bf16x8 pa2, bf16x8 pa3) {
  pv_one<0>(o[0], vb, pa0, pa1, pa2, pa3); pv_one<1>(o[1], vb, pa0, pa1, pa2, pa3); pv_one<2>(o[2], vb, pa0, pa1, pa2, pa3); pv_one<3>(o[3], vb, pa0, pa1, pa2, pa3);
}
template <bool NA, int LDQ>
__device__ __forceinline__ unsigned attn_unit(char* lds, const bf16* __restrict__ Qb, const bf16* __restrict__ Kh, const bf16* __restrict__ Vh, bf16* __restrict__ Ob,
                                          int nt, int kt0, int r0, const float* __restrict__ rpb, float* __restrict__ ssq, int ssq_stride, unsigned* next_head) {
  constexpr int LDK = 1024, LDO = 2048;
  int tid_ = threadIdx.x; asm volatile("" : "+v"(tid_));
  const int tid = tid_, wid = tid >> 6, lane = tid & 63, r32 = lane & 31, hi = lane >> 5;
  bf16* V_lds = (bf16*)lds; bf16* K_lds = (bf16*)(lds + OFF_K);
  float* wsf = (float*)(lds + OFF_WS) + wid * 64; float* li_l = wsf; float* al_l = wsf + 32;
  float* tab = (float*)(lds + OFF_TAB);
  float m_reg = -1e30f, l_reg = 0; f32x16 o[4] = {}; bf16x8 qr[8];
  const bf16* Qw = Qb + (long)(wid * QBLK + r32) * LDQ + hi * 8;
#pragma unroll
  for (int d0 = 0; d0 < 8; ++d0) qr[d0] = *reinterpret_cast<const bf16x8*>(Qw + d0 * 16);
  const int sr = tid >> 4, sc = (tid & 15) * 8, vst0 = v_st(sr, sc), vst1 = v_st(32 + sr, sc);
  const int vb0 = (int)(uintptr_t)V_lds + v_rd_base(lane);
  int rs = 0, t0 = 0, bidx0 = 0;
  if (NA) {
    for (int i = tid; i < 640; i += 512) { const int idx = i - 48; tab[i] = (idx >= 0 && idx < 465) ? rpb[idx] * (1.0f / SCALE) : 0.f; }
    const int r = r0 + (wid >> 1), c = 32 * (wid & 1) + r32;
    rs = min(max(r - 4, 0), 248); const int cs = min(max(c - 8, 0), 48);
    t0 = 4 * hi - cs;
    bidx0 = 48 + (7 - r) * 31 - c + 15 + 4 * hi;
  }
  struct StageRegs { bf16x8 vs0, vs1, ks0, ks1; } sA, sB;
const bf16* Vt = Vh + (long)sr * LDK + sc; const bf16* Kt = Kh + (long)sr * LDK + sc;
#define SLOAD(S, k0) do { const long o_ = (long)__builtin_amdgcn_readfirstlane(k0) * LDK; S.vs0 = *reinterpret_cast<const bf16x8*>(Vt + o_); S.vs1 = *reinterpret_cast<const bf16x8*>(Vt + o_ + 32 * LDK); \
    S.ks0 = *reinterpret_cast<const bf16x8*>(Kt + o_); S.ks1 = *reinterpret_cast<const bf16x8*>(Kt + o_ + 32 * LDK); } while (0)
#define SWRITE(b, S) do { *(bf16x8*)((char*)V_lds + (b) * SHM_V + vst0) = S.vs0; *(bf16x8*)((char*)V_lds + (b) * SHM_V + vst1) = S.vs1; const int kc_ = sc * 2;               \
    *(bf16x8*)((char*)K_lds + (b) * SHM_K + KSWZ(sr, kc_)) = S.ks0; *(bf16x8*)((char*)K_lds + (b) * SHM_K + KSWZ(32 + sr, kc_)) = S.ks1; } while (0)
#define TILE(buf, kr) do { const bool active = NA ? ((kr) >= rs && (kr) <= rs + 7) : true;        \
    if (active) { f32x16 p0, p1; float mn, alpha; bf16x8 pa0, pa1, pa2, pa3; \
      SBAR(); qkt(p0, p1, (const bf16*)((const char*)K_lds + (buf) * SHM_K), qr, r32, hi); \
      if (NA) { const int bi = bidx0 + (kr) * 31; \
        _Pragma("unroll") for (int r = 0; r < 16; ++r) { const int kofs = (r & 3) + 8 * (r >> 2); \
          { const float b = tab[bi + kofs]; p0[r] = ((unsigned)(t0 + kofs) < 16u) ? p0[r] + b : -__builtin_inff(); } \
          { const float b = tab[bi + 32 + kofs]; p1[r] = ((unsigned)(t0 + 32 + kofs) < 16u) ? p1[r] + b : -__builtin_inff(); } } } \
      partialSM(p0, p1, m_reg, mn, alpha); \
      if (__any(alpha < 1.f)) { if (hi == 0) al_l[r32] = alpha; asm volatile("s_waitcnt lgkmcnt(0)" ::: "memory"); \
        _Pragma("unroll") for (int d = 0; d < 4; ++d) _Pragma("unroll") for (int r = 0; r < 16; ++r) o[d][r] *= al_l[crow(r, hi)]; } \
      finishSM(p0, p1, alpha, l_reg, pa0, pa1, pa2, pa3); SBAR(); \
      pv_d0(o, vb0 + (buf) * SHM_V, pa0, pa1, pa2, pa3); } } while (0)
  const int klast = kt0 + nt - 1;
  SLOAD(sA, kt0 * 64); SLOAD(sB, (kt0 + 1) * 64); SWRITE(0, sA); SLOAD(sA, min(kt0 + 2, klast) * 64); __syncthreads();
  for (int j = 0; j < nt; j += 2) {
    const int kr = kt0 + j;
    TILE(0, kr);
    SWRITE(1, sB); SLOAD(sB, min(kr + 3, klast) * 64);
    __syncthreads();
    TILE(1, kr + 1);
    SWRITE(0, sA); SLOAD(sA, min(kr + 4, klast) * 64);
    __syncthreads();
  }
  const unsigned next_ticket = (tid == 0) ? __hip_atomic_fetch_add(next_head, 1u, __ATOMIC_RELAXED, __HIP_MEMORY_SCOPE_AGENT) : 0u;
  if (hi == 0) li_l[r32] = l_reg; asm volatile("s_waitcnt lgkmcnt(0)" ::: "memory");
  float rli[16];
#pragma unroll
  for (int r = 0; r < 16; ++r) rli[r] = __builtin_amdgcn_rcpf(li_l[crow(r, hi)]);
#pragma unroll
  for (int r = 0; r < 16; ++r) { float v = 0.f;
#pragma unroll
    for (int d0 = 0; d0 < 4; ++d0) { const float t = o[d0][r] * rli[r]; v += t * t; }
    v += __shfl_xor(v, 1); v += __shfl_xor(v, 2); v += __shfl_xor(v, 4); v += __shfl_xor(v, 8); v += __shfl_xor(v, 16);
    if (r32 == 0) ssq[(long)(wid * QBLK + crow(r, hi)) * ssq_stride] = v; }
  bf16* Ow = Ob + (long)(wid * QBLK) * LDO;
  const bool odd = (r32 & 1) != 0;
#pragma unroll
  for (int r = 0; r < 16; r += 2) { const int orow = crow(odd ? r + 1 : r, hi);
#pragma unroll
    for (int d0 = 0; d0 < 4; ++d0) { const float mine0 = o[d0][r] * rli[r], mine1 = o[d0][r + 1] * rli[r + 1];
      const float got = __shfl_xor(odd ? mine0 : mine1, 1);
      const unsigned w = odd ? cvtpk(got, mine1) : cvtpk(mine0, got);
      *(unsigned*)(Ow + (long)orow * LDO + d0 * 32 + (r32 & ~1)) = w; } }
#undef TILE
#undef SLOAD
#undef SWRITE
  return next_ticket;
}
__device__ __forceinline__ void partialSM1(f32x16& p0, float& m_reg, float& mn, float& alpha) {
  constexpr float C = SCALE * 1.4426950408889634f;
  float pmax = p0[0]; for (int r = 1; r < 16; ++r) pmax = fmaxf(pmax, p0[r]);
  { auto rr = __builtin_amdgcn_permlane32_swap(__float_as_uint(pmax), __float_as_uint(pmax), false, false);
    pmax = fmaxf(__uint_as_float(rr[0]), __uint_as_float(rr[1])); }
  if (__builtin_expect(__all(pmax - m_reg <= THR / SCALE), 1)) { mn = m_reg; alpha = 1.f; }
  else { mn = fmaxf(m_reg, pmax); alpha = __builtin_amdgcn_exp2f((m_reg - mn) * C); m_reg = mn; }
  const float mnC = -mn * C;
  for (int r = 0; r < 16; ++r) p0[r] = __builtin_amdgcn_exp2f(fmaf(p0[r], C, mnC));
}
__device__ __forceinline__ void finishSM1(f32x16& p0, float alpha, float& l_reg, bf16x8& pa0, bf16x8& pa1) {
  float ps = 0; for (int r = 0; r < 16; ++r) ps += p0[r];
  { auto rr = __builtin_amdgcn_permlane32_swap(__float_as_uint(ps), __float_as_uint(ps), false, false);
    ps = __uint_as_float(rr[0]) + __uint_as_float(rr[1]); }
  l_reg = l_reg * alpha + ps;
#define PK4(P, BASE, OUT) do { unsigned a0 = cvtpk(P[BASE + 0], P[BASE + 1]), a1 = cvtpk(P[BASE + 2], P[BASE + 3]);   \
    unsigned b0 = cvtpk(P[BASE + 4], P[BASE + 5]), b1 = cvtpk(P[BASE + 6], P[BASE + 7]);                              \
    auto r0 = __builtin_amdgcn_permlane32_swap(a0, b0, false, false); auto r1 = __builtin_amdgcn_permlane32_swap(a1, b1, false, false); \
    u32x4 w = {r0[0], r1[0], r0[1], r1[1]}; OUT = *reinterpret_cast<bf16x8*>(&w); } while (0)
  PK4(p0, 0, pa0); PK4(p0, 8, pa1);
#undef PK4
}
template <int D0> __device__ __forceinline__ void pv_one2(f32x16& od, int vb, bf16x8 pa0, bf16x8 pa1) {
  const s16x4 l0 = tr_read<v_rd_off(D0, 0, 0)>(vb), h0 = tr_read<v_rd_off(D0, 0, 1)>(vb), l1 = tr_read<v_rd_off(D0, 1, 0)>(vb), h1 = tr_read<v_rd_off(D0, 1, 1)>(vb);
  asm volatile("s_waitcnt lgkmcnt(0)" ::: "memory"); SBAR();
#define PK(L, H) (bf16x8){L[0], L[1], L[2], L[3], H[0], H[1], H[2], H[3]}
  od = __builtin_amdgcn_mfma_f32_32x32x16_bf16(pa0, PK(l0, h0), od, 0, 0, 0);
  od = __builtin_amdgcn_mfma_f32_32x32x16_bf16(pa1, PK(l1, h1), od, 0, 0, 0);
#undef PK
}
constexpr int NA_TAB = 864 + 576;
__device__ __forceinline__ unsigned na_unit(char* lds, const bf16* __restrict__ Qb, const bf16* __restrict__ Kh, const bf16* __restrict__ Vh, bf16* __restrict__ Ob,
                                        int nt, int kt0, int kr_hi, int r0, const float* __restrict__ rpb, float* __restrict__ ssq, unsigned* next_head) {
  constexpr int LDQ = 1024, LDK = 1024, LDO = 2048;
  int tid_ = threadIdx.x; asm volatile("" : "+v"(tid_));
  const int tid = tid_, wid = __builtin_amdgcn_readfirstlane(tid >> 6), lane = tid & 63, r32 = lane & 31, hi = lane >> 5;
  constexpr int NA_OFF_K = 4 * SHM_V, NA_OFF_WS = 4 * SHM_V + 4 * SHM_K, NA_OFF_TAB = NA_OFF_WS + NW * 64 * 4;
  bf16* V_lds = (bf16*)lds; bf16* K_lds = (bf16*)(lds + NA_OFF_K);
  float* wsf = (float*)(lds + NA_OFF_WS) + wid * 64; float* li_l = wsf; float* al_l = wsf + 32;
  float* tab = (float*)(lds + NA_OFF_TAB);
  float m_reg = -1e30f, l_reg = 0; f32x16 o[4] = {}; bf16x8 qr[8];
  const int kb = wid <= 2 ? 0 : (wid <= 4 ? 16 : 32);
  const int qrow = r32 >> 3, qcol = 8 * wid + (r32 & 7);
  const bf16* Qw = Qb + (long)(qrow * 64 + qcol) * LDQ + hi * 8;
#pragma unroll
  for (int d0 = 0; d0 < 8; ++d0) qr[d0] = *reinterpret_cast<const bf16x8*>(Qw + d0 * 16);
  const int sr = tid >> 4, sc = (tid & 15) * 8, vst0 = v_st(sr, sc), vst1 = v_st(32 + sr, sc);
  const int vb0 = (int)(uintptr_t)V_lds + v_rd_base(lane) + (kb >> 4) * 4096;
  const bool edge_unit = (r0 == 0) || (r0 == 252);
  for (int i = tid; i < 864 + 576; i += 512) { float v = -__builtin_inff();
    if (i < 864) { const int row = i / 48, dc = i % 48 - 23, dr = row - 7; const bool ok = (edge_unit ? row <= 14 : (dr >= -4 && dr <= 3)) && dc >= -8 && dc <= 7; if (ok) v = rpb[row * 31 + dc + 15] * (1.0f / SCALE); }
    else { const int jj = i - 864, row = jj >> 5, col = jj & 31, dr = row - 7; const bool ok = (edge_unit ? row <= 14 : (dr >= -4 && dr <= 3)) && col <= 30; if (ok) v = rpb[row * 31 + col] * (1.0f / SCALE); }
    tab[i] = v; }
  const int rq = r0 + qrow;
  const int wt = wid == 0 ? 1 : (wid == 7 ? 2 : 0);
  const int bidx0 = wt == 0 ? (7 - rq) * 48 + kb + 4 * hi - qcol + 23 : 864 + (7 - rq) * 32 + kb + 4 * hi - qcol + 15;
  const int bpitch = wt == 0 ? 48 : 32;
  const bf16* Vt = Vh + (long)sr * LDK + sc; const bf16* Kt = Kh + (long)sr * LDK + sc;
  bf16x8 vsA0, vsA1, ksA0, ksA1, vsB0, vsB1, ksB0, ksB1;
#define SLOAD(k0) do { const long o_ = (long)__builtin_amdgcn_readfirstlane(k0) * LDK; \
    vsA0 = *reinterpret_cast<const bf16x8*>(Vt + o_); vsA1 = *reinterpret_cast<const bf16x8*>(Vt + o_ + 32 * LDK); ksA0 = *reinterpret_cast<const bf16x8*>(Kt + o_); ksA1 = *reinterpret_cast<const bf16x8*>(Kt + o_ + 32 * LDK); \
    vsB0 = *reinterpret_cast<const bf16x8*>(Vt + o_ + 64 * LDK); vsB1 = *reinterpret_cast<const bf16x8*>(Vt + o_ + 96 * LDK); ksB0 = *reinterpret_cast<const bf16x8*>(Kt + o_ + 64 * LDK); ksB1 = *reinterpret_cast<const bf16x8*>(Kt + o_ + 96 * LDK); } while (0)
#define SWRITE(b) do { const int kc_ = sc * 2; \
    *(bf16x8*)((char*)V_lds + (2 * (b)) * SHM_V + vst0) = vsA0; *(bf16x8*)((char*)V_lds + (2 * (b)) * SHM_V + vst1) = vsA1; \
    *(bf16x8*)((char*)K_lds + (2 * (b)) * SHM_K + KSWZ(sr, kc_)) = ksA0; *(bf16x8*)((char*)K_lds + (2 * (b)) * SHM_K + KSWZ(32 + sr, kc_)) = ksA1; \
    *(bf16x8*)((char*)V_lds + (2 * (b) + 1) * SHM_V + vst0) = vsB0; *(bf16x8*)((char*)V_lds + (2 * (b) + 1) * SHM_V + vst1) = vsB1; \
    *(bf16x8*)((char*)K_lds + (2 * (b) + 1) * SHM_K + KSWZ(sr, kc_)) = ksB0; *(bf16x8*)((char*)K_lds + (2 * (b) + 1) * SHM_K + KSWZ(32 + sr, kc_)) = ksB1; } while (0)
#define PINIT(P, KR) do { const int bi = bidx0 + (KR) * bpitch; \
    if (wt == 0) { _Pragma("unroll") for (int r = 0; r < 16; ++r) P[r] = tab[bi + (r & 3) + 8 * (r >> 2)]; } \
    else if (wt == 1) { _Pragma("unroll") for (int r = 0; r < 16; ++r) P[r] = r < 8 ? tab[bi + (r & 3) + 8 * (r >> 2)] : -__builtin_inff(); } \
    else { _Pragma("unroll") for (int r = 0; r < 16; ++r) P[r] = r >= 8 ? tab[bi + (r & 3) + 8 * (r >> 2)] : -__builtin_inff(); } } while (0)
#define QKT(P, SLOT) do { const bf16* Ks = (const bf16*)((const char*)K_lds + (SLOT) * SHM_K); \
    _Pragma("unroll") for (int d0 = 0; d0 < 8; ++d0) { const int cb = (d0 * 16 + hi * 8) * 2; \
      const bf16x8 b0 = *reinterpret_cast<const bf16x8*>((const char*)Ks + KSWZ(kb + r32, cb)); \
      P = __builtin_amdgcn_mfma_f32_32x32x16_bf16(b0, qr[d0], P, 0, 0, 0); } } while (0)
#define SMPV(P, SLOT) do { float mn, alpha; bf16x8 pa0, pa1; partialSM1(P, m_reg, mn, alpha); \
    if (__any(alpha < 1.f)) { if (hi == 0) al_l[r32] = alpha; asm volatile("s_waitcnt lgkmcnt(0)" ::: "memory"); \
      _Pragma("unroll") for (int d = 0; d < 4; ++d) _Pragma("unroll") for (int r = 0; r < 16; ++r) o[d][r] *= al_l[crow(r, hi)]; } \
    finishSM1(P, alpha, l_reg, pa0, pa1); SBAR(); const int vb = vb0 + (SLOT) * SHM_V; \
    pv_one2<0>(o[0], vb, pa0, pa1); pv_one2<1>(o[1], vb, pa0, pa1); pv_one2<2>(o[2], vb, pa0, pa1); pv_one2<3>(o[3], vb, pa0, pa1); } while (0)
  const int nsteps = nt >> 1;
  SLOAD(kt0 * 64); SWRITE(0); __syncthreads();
  for (int st = 0; st < nsteps; ++st) {
    const int b = st & 1, kr = kt0 + 2 * st;
    if (st + 1 < nsteps) SLOAD((kr + 2) * 64);
    const bool validB = kr + 1 <= kr_hi;
    f32x16 pA, pB;
    SBAR();
    PINIT(pA, kr); if (validB) PINIT(pB, kr + 1);
    QKT(pA, 2 * b); if (validB) QKT(pB, 2 * b + 1);
    SMPV(pA, 2 * b);
    if (validB) SMPV(pB, 2 * b + 1);
    if (st + 1 < nsteps) SWRITE(b ^ 1);
    __syncthreads();
  }
#undef PINIT
#undef QKT
#undef SMPV
  const unsigned next_ticket = (tid == 0) ? __hip_atomic_fetch_add(next_head, 1u, __ATOMIC_RELAXED, __HIP_MEMORY_SCOPE_AGENT) : 0u;
  if (hi == 0) li_l[r32] = l_reg; asm volatile("s_waitcnt lgkmcnt(0)" ::: "memory");
  float rli[16];
#pragma unroll
  for (int r = 0; r < 16; ++r) rli[r] = __builtin_amdgcn_rcpf(li_l[crow(r, hi)]);
#pragma unroll
  for (int r = 0; r < 16; ++r) { float v = 0.f;
#pragma unroll
    for (int d0 = 0; d0 < 4; ++d0) { const float t = o[d0][r] * rli[r]; v += t * t; }
    v += __shfl_xor(v, 1); v += __shfl_xor(v, 2); v += __shfl_xor(v, 4); v += __shfl_xor(v, 8); v += __shfl_xor(v, 16);
    const int qi = crow(r, hi);
    if (r32 == 0) ssq[(long)((qi >> 3) * 64 + 8 * wid + (qi & 7)) * 8] = v; }
  const bool odd = (r32 & 1) != 0;
#pragma unroll
  for (int r = 0; r < 16; r += 2) { const int qi = crow(odd ? r + 1 : r, hi); bf16* orow = Ob + (long)((qi >> 3) * 64 + 8 * wid + (qi & 7)) * LDO;
#pragma unroll
    for (int d0 = 0; d0 < 4; ++d0) { const float mine0 = o[d0][r] * rli[r], mine1 = o[d0][r + 1] * rli[r + 1];
      const float got = __shfl_xor(odd ? mine0 : mine1, 1);
      const unsigned w = odd ? cvtpk(got, mine1) : cvtpk(mine0, got);
      *(unsigned*)(orow + d0 * 32 + (r32 & ~1)) = w; } }
#undef SLOAD
#undef SWRITE
  return next_ticket;
}
#undef KSWZ
#undef SBAR
}

struct Frame {
    LAS unsigned char* lds;
    volatile LAS unsigned* MISC;
    gu32* ctl;
    int tid, lane, wave;
    int vcu, G;
    const float* const* in; float* out; unsigned char* ws;
};
__device__ __forceinline__ float wave_sum(float v) {
#pragma unroll
    for (int o = 1; o < 64; o <<= 1) v += __shfl_xor(v, o);
    return v;
}
__device__ __forceinline__ float wave_max(float v) {
#pragma unroll
    for (int o = 1; o < 64; o <<= 1) v = fmaxf(v, __shfl_xor(v, o));
    return v;
}
__device__ __forceinline__ void p0_transpose_item(const float* W, int K, int N, bf16* WT, const float* gain, LAS float* scr, int item, int lane, int kperm = 0) {
    const int nblk = N / 32, kb = item / nblk, nb = item % nblk, k0 = 64 * kb, n0 = 32 * nb;
    const int kd = kperm ? (k0 < 1024 ? k0 : (k0 < 1536 ? k0 + 512 : k0 - 512)) : k0;
    const GAS float* src = (const GAS float*)W + (size_t)(k0 + (lane >> 5)) * N + n0 + (lane & 31);
    float v[32];
#pragma unroll
    for (int i = 0; i < 32; ++i) v[i] = src[(size_t)(2 * i) * N];
    if (gain) {
#pragma unroll
        for (int i = 0; i < 32; ++i) v[i] *= gain[k0 + 2 * i + (lane >> 5)]; }
#pragma unroll
    for (int i = 0; i < 32; ++i) scr[(2 * i + (lane >> 5)) * 33 + (lane & 31)] = v[i];
    LDS_WAIT(); asm volatile("" ::: "memory");
    const int c = lane & 7;
#pragma unroll
    for (int j = 0; j < 4; ++j) { const int n = (lane >> 3) + 8 * j; const LAS float* s = scr + (8 * c) * 33 + n;
        v4u o; o.x = pk2(s[0 * 33], s[1 * 33]); o.y = pk2(s[2 * 33], s[3 * 33]); o.z = pk2(s[4 * 33], s[5 * 33]); o.w = pk2(s[6 * 33], s[7 * 33]);
        *(GAS v4u*)(WT + (size_t)(n0 + n) * K + kd + 8 * c) = o; }
    LDS_WAIT(); asm volatile("" ::: "memory");
}
__device__ __forceinline__ void rms_row_to_bf16(int lane, const float* xrow, bf16* orow) {
    const GAS f32x4* xr = (const GAS f32x4*)xrow + lane;
    f32x4 v[8]; float s = 0.f;
#pragma unroll
    for (int j = 0; j < 8; ++j) { v[j] = xr[64 * j]; s += (v[j].x * v[j].x + v[j].y * v[j].y) + (v[j].z * v[j].z + v[j].w * v[j].w); }
    const float rs = 1.f / sqrtf(wave_sum(s) * (1.f / DM) + EPS);
    GAS unsigned long long* o8 = (GAS unsigned long long*)orow + lane;
#pragma unroll
    for (int j = 0; j < 8; ++j) o8[64 * j] = (unsigned long long)pk2(v[j].x * rs, v[j].y * rs) | ((unsigned long long)pk2(v[j].z * rs, v[j].w * rs) << 32);
}
__device__ __forceinline__ void p0_ssm_group(Frame& F, int g, int ch) {
    typedef float f32x2 __attribute__((ext_vector_type(2)));
    LAS f32x2* PW = (LAS f32x2*)(F.lds);
    LAS f32x2* BB = (LAS f32x2*)(F.lds + 33280);
    LAS f32x2* CC = (LAS f32x2*)(F.lds + 33280 + 8192);
    LAS bf16* KM = (LAS bf16*)(F.lds + 49664);
    const float *lam_re = F.in[5], *lam_im = F.in[6], *log_dt = F.in[7], *b_re = F.in[8], *b_im = F.in[9], *c_re = F.in[10], *c_im = F.in[11], *dd = F.in[12];
    bf16* Pm = (bf16*)(F.ws + WS_PM) + (size_t)g * 256 * 1024;
    bf16* BtD = (bf16*)(F.ws + WS_BTD) + (size_t)g * 1024 * UPITCH;
    f32x2* A64 = (f32x2*)(F.ws + WS_A64);
    const int tid = F.tid;
    const int pairl = tid & 127, kc = 8 * ch + (pairl >> 4), kcp = pairl & 15, quarter = tid >> 7;
    float k0sum = 0.f;
    for (int dir = 0; dir < 2; ++dir) {
        const int dg = dir * NGRP + g;
        const double dt = exp((double)log_dt[dg]);
        for (int e = tid; e < 64 * 65; e += 512) { const int p = e / 65, tau = e % 65;
            const double lr = fmin((double)lam_re[dg * 64 + p], -1e-4), li = (double)lam_im[dg * 64 + p];
            const double mag = exp(tau * dt * lr); const double sn = sin(tau * dt * li), cs = cos(tau * dt * li);
            PW[e] = (f32x2){(float)(mag * cs), (float)(mag * sn)};
            if (tau == 64 && ch == 0) A64[dg * 64 + p] = (f32x2){(float)(mag * cs), (float)(mag * sn)}; }
        for (int e = tid; e < 1024; e += 512) { const int p = e >> 4, c = e & 15;
            const double lr = fmin((double)lam_re[dg * 64 + p], -1e-4), li = (double)lam_im[dg * 64 + p];
            const double mag = exp(dt * lr); const double sn = sin(dt * li), cs = cos(dt * li);
            const double ar = mag * cs - 1.0, ai = mag * sn, den = lr * lr + li * li;
            const double qr = (ar * lr + ai * li) / den, qi = (ai * lr - ar * li) / den;
            const double br = (double)b_re[(size_t)(dg * 64 + p) * 16 + c], bi = (double)b_im[(size_t)(dg * 64 + p) * 16 + c];
            BB[e] = (f32x2){(float)(qr * br - qi * bi), (float)(qr * bi + qi * br)}; }
        for (int e = tid; e < 1024; e += 512) CC[e] = (f32x2){c_re[(size_t)dg * 1024 + e], c_im[(size_t)dg * 1024 + e]};
        __syncthreads();
        { float acc[16];
#pragma unroll
          for (int t = 0; t < 16; ++t) acc[t] = 0.f;
          for (int p = 0; p < 64; ++p) { const f32x2 c = CC[kc * 64 + p], b = BB[p * 16 + kcp]; const float cbr = c.x * b.x - c.y * b.y, cbi = c.x * b.y + c.y * b.x;
#pragma unroll
              for (int t = 0; t < 16; ++t) { const f32x2 w = PW[p * 65 + quarter * 16 + t]; acc[t] += cbr * w.x - cbi * w.y; } }
#pragma unroll
          for (int t = 0; t < 16; ++t) { const int tau = quarter * 16 + t;
              if (tau == 0) k0sum += acc[t];
              else KM[(dir == 0 ? 63 + tau : 63 - tau) * 128 + pairl] = (bf16)f2bf(acc[t]); } }
        for (int it = tid; it < 32 * 64 * 2; it += 512) { const int hc = it & 1, s = (it >> 1) & 63, p = 32 * ch + (it >> 7);
            const f32x2 w = PW[p * 65 + (dir == 0 ? 63 - s : s)]; float re[8], im[8];
#pragma unroll
            for (int j = 0; j < 8; ++j) { const f32x2 b = BB[p * 16 + hc * 8 + j]; re[j] = w.x * b.x - w.y * b.y; im[j] = w.x * b.y + w.y * b.x; }
            v4u o; o.x = pk2(re[0], re[1]); o.y = pk2(re[2], re[3]); o.z = pk2(re[4], re[5]); o.w = pk2(re[6], re[7]);
            *(GAS v4u*)(Pm + (size_t)(dir * 128 + p) * 1024 + s * 16 + hc * 8) = o;
            o.x = pk2(im[0], im[1]); o.y = pk2(im[2], im[3]); o.z = pk2(im[4], im[5]); o.w = pk2(im[6], im[7]);
            *(GAS v4u*)(Pm + (size_t)(dir * 128 + 64 + p) * 1024 + s * 16 + hc * 8) = o; }
        for (int it = tid; it < 512 * 8; it += 512) { const int oc = it & 7, rl = it >> 3, t = rl >> 3, c = 8 * ch + (rl & 7), row = t * 16 + c; float re[8], im[8];
#pragma unroll
            for (int j = 0; j < 8; ++j) { const int p = oc * 8 + j; const f32x2 w = PW[p * 65 + (dir == 0 ? t + 1 : 64 - t)], cc = CC[c * 64 + p]; re[j] = cc.x * w.x - cc.y * w.y; im[j] = -(cc.x * w.y + cc.y * w.x); }
            v4u o; o.x = pk2(re[0], re[1]); o.y = pk2(re[2], re[3]); o.z = pk2(re[4], re[5]); o.w = pk2(re[6], re[7]);
            *(GAS v4u*)(BtD + (size_t)row * UPITCH + 1024 + dir * 128 + oc * 8) = o;
            o.x = pk2(im[0], im[1]); o.y = pk2(im[2], im[3]); o.z = pk2(im[4], im[5]); o.w = pk2(im[6], im[7]);
            *(GAS v4u*)(BtD + (size_t)row * UPITCH + 1024 + dir * 128 + 64 + oc * 8) = o; }
        __syncthreads();
    }
    if (quarter == 0) KM[63 * 128 + pairl] = (bf16)f2bf(k0sum + (kc == kcp ? dd[g * 16 + kc] : 0.f));
    __syncthreads();
    for (int it = tid; it < 512 * 128; it += 512) { const int q = it & 127, rl = it >> 7, t = rl >> 3, cl = rl & 7, s = q >> 1, hc = q & 1;
        const v4u o = *(const LAS v4u*)(KM + (size_t)(t - s + 63) * 128 + cl * 16 + hc * 8);
        *(GAS v4u*)(BtD + (size_t)(t * 16 + 8 * ch + cl) * UPITCH + s * 16 + hc * 8) = o; }
    __syncthreads();
}
__device__ __forceinline__ unsigned wq_issue(Frame& F, gu32* head, int chunk) { return F.tid == 0 ? __hip_atomic_fetch_add(head, (unsigned)chunk, RLX_AGENT) : 0u; }
__device__ __forceinline__ int wq_take(Frame& F, unsigned ticket) {
    __syncthreads();
    if (F.tid == 0) F.MISC[4] = ticket;
    __syncthreads();
    return (int)F.MISC[4];
}
__device__ __forceinline__ void grp_sync(Frame& F, gu32* cnt, unsigned target) {
    VM_WAIT(); __syncthreads();
    if (F.tid == 0) { __hip_atomic_fetch_add(cnt, 1u, RLX_AGENT); unsigned sp = 0;
        while (__hip_atomic_load(cnt, RLX_AGENT) < target) { __builtin_amdgcn_s_sleep(4); if (++sp > (1u << 22)) break; }
        __builtin_amdgcn_fence(__ATOMIC_ACQUIRE, "agent"); VM_WAIT(); }
    __syncthreads();
}
__device__ __forceinline__ int wg_dequeue(Frame& F, gu32* head, int chunk) {
    __syncthreads();
    if (F.tid == 0) F.MISC[4] = __hip_atomic_fetch_add(head, (unsigned)chunk, RLX_AGENT);
    __syncthreads();
    return (int)F.MISC[4];
}
constexpr int KV_WG0 = 64;
constexpr int KV_ITEMS = (DM / 64) * (1024 / 32) + NMEM;
__device__ __forceinline__ void p0_prologue(Frame& F, int rep) {
    LAS float* scr = (LAS float*)(F.lds + RING_OFF + F.wave * 16384);
    if (blockIdx.x < 2 * NGRP) p0_ssm_group(F, blockIdx.x >> 1, blockIdx.x & 1);
    else if (blockIdx.x < KV_WG0 + 4) {
        const int j = blockIdx.x - KV_WG0;
        if (F.tid == 0) { unsigned sp = 0; while (__hip_atomic_load(F.ctl + CW_KVD, RLX_AGENT) < (unsigned)KV_ITEMS) { __builtin_amdgcn_s_sleep(8); if (++sp > (1u << 22)) break; }
            __builtin_amdgcn_fence(__ATOMIC_ACQUIRE, "agent"); VM_WAIT(); }
        __syncthreads();
        pg8::Gemm g{(const pg8::bf16_t*)(F.ws + WS_MEMN), (const pg8::bf16_t*)(F.ws + WS_WKV), DM, DM, DM, 0}; pg8::OneUnit S; S.u = pg8::Unit{0, j, 0, j};
        pg8::EpiBf16<0> E{(pg8::bf16_t*)(F.ws + WS_KVM), 1024};
        pg8::gemm_phase<pg8::EpiBf16<0>, pg8::OneUnit, true, true>(F.lds + RING_OFF, g, S, E);
    }
    constexpr int I_KV = (DM / 64) * (1024 / 32), I_IN = (DM / 64) * (INW / 32), I_OUT = (DM / 64) * (DM / 32), I_F1 = (DM / 64) * (DFF / 32), I_F2 = (DFF / 64) * (DM / 32), I_GLU = (512 / 64) * (512 / 32);
    constexpr int NTR = KV_ITEMS + I_IN + I_OUT + I_F1 + I_F2 + I_GLU, NITEMS = NTR + SEQ, CHUNK = 8;
    static_assert(KV_ITEMS % CHUNK == 0, "KV items fill whole chunks");
    for (unsigned tk = wq_issue(F, F.ctl + CW_Q0, CHUNK);;) {
        const int base = wq_take(F, tk); if (base >= NITEMS) break; tk = wq_issue(F, F.ctl + CW_Q0, CHUNK);
        for (int it = base + F.wave; it < base + CHUNK && it < NITEMS; it += NWAVES) {
            int r = it;
            if (r >= NTR) { const int m = r - NTR; rms_row_to_bf16(F.lane, F.in[0] + (size_t)m * DM, (bf16*)(F.ws + WS_XN) + (size_t)m * DM); continue; }
            if (r < I_KV) { p0_transpose_item(F.in[16], DM, 1024, (bf16*)(F.ws + WS_WKV), F.in[15], scr, r, F.lane); continue; } r -= I_KV;
            if (r < NMEM) { rms_row_to_bf16(F.lane, F.in[1] + (size_t)r * DM, (bf16*)(F.ws + WS_MEMN) + (size_t)r * DM); continue; } r -= NMEM;
            if (r < I_IN) { p0_transpose_item(F.in[3], DM, INW, (bf16*)(F.ws + WS_WIN), F.in[2], scr, r, F.lane); continue; } r -= I_IN;
            if (r < I_OUT) { const int kb = r / (DM / 32), k0 = kb * 64;
                const float* gain = k0 < 1024 ? F.in[17] : (k0 < 1536 ? F.in[18] - 1024 : F.in[19] - 1536);
                p0_transpose_item(F.in[20], DM, DM, (bf16*)(F.ws + WS_WOUT), gain, scr, r, F.lane, 1); continue; } r -= I_OUT;
            if (r < I_F1) { p0_transpose_item(F.in[23], DM, DFF, (bf16*)(F.ws + WS_WFF1), F.in[22], scr, r, F.lane); continue; } r -= I_F1;
            if (r < I_F2) { p0_transpose_item(F.in[24], DFF, DM, (bf16*)(F.ws + WS_W2T), nullptr, scr, r, F.lane); continue; } r -= I_F2;
            p0_transpose_item(F.in[13], 512, 512, (bf16*)(F.ws + WS_WGLU), nullptr, scr, r, F.lane);
        }
        if (base < KV_ITEMS) {
            VM_WAIT(); __syncthreads();
            if (F.tid == 0) { __builtin_amdgcn_fence(__ATOMIC_RELEASE, "agent"); VM_WAIT(); __hip_atomic_fetch_add(F.ctl + CW_KVD, (unsigned)CHUNK, RLX_AGENT); }
        }
    }
}
template <bool NA>
__device__ __forceinline__ void naive_attn_task(Frame& F, int token, int h) {
    constexpr int NKL = NA ? 2 : 4;
    const int lane = F.lane;
    const bf16* Qn = (const bf16*)(F.ws + WS_QN); const bf16* Kn = (const bf16*)(F.ws + WS_KN); const bf16* Vn = (const bf16*)(F.ws + WS_VN);
    const bf16* Qm = (const bf16*)(F.ws + WS_QM); const bf16* KV = (const bf16*)(F.ws + WS_KVM); bf16* Y = (bf16*)(F.ws + WS_Y);
    const bf16* qp = NA ? Qn + (size_t)token * 1024 + h * 128 : Qm + (size_t)token * 512 + h * 128;
    bf16x8 q[16];
#pragma unroll
    for (int i = 0; i < 16; ++i) q[i] = *(const GAS bf16x8*)(qp + 8 * i);
    const int r = token >> 6, c = token & 63;
    const int rs = min(max(r - 4, 0), 248), cs = min(max(c - 8, 0), 48);
    float sc[NKL]; float mx = -1e30f;
#pragma unroll
    for (int kk = 0; kk < NKL; ++kk) { const int kidx = lane + 64 * kk; int ktok; float bias = 0.f;
        if (NA) { const int kr = rs + (kidx >> 4), kcl = cs + (kidx & 15); ktok = kr * 64 + kcl; bias = F.in[4][h * 465 + (kr - r + 7) * 31 + (kcl - c + 15)]; } else ktok = kidx;
        const bf16* kp = NA ? Kn + (size_t)ktok * 1024 + h * 128 : KV + (size_t)ktok * 1024 + h * 128;
        float dot = 0.f;
#pragma unroll
        for (int i = 0; i < 16; ++i) { const bf16x8 kv = *(const GAS bf16x8*)(kp + 8 * i);
#pragma unroll
            for (int e = 0; e < 8; ++e) dot += __uint_as_float(((unsigned)(unsigned short)q[i][e]) << 16) * __uint_as_float(((unsigned)(unsigned short)kv[e]) << 16); }
        sc[kk] = dot * 0.08838834764831845f + bias; mx = fmaxf(mx, sc[kk]); }
    mx = wave_max(mx); float sum = 0.f;
#pragma unroll
    for (int kk = 0; kk < NKL; ++kk) { sc[kk] = __expf(sc[kk] - mx); sum += sc[kk]; }
    sum = wave_sum(sum);
    float o0 = 0.f, o1 = 0.f;
#pragma unroll
    for (int kk = 0; kk < NKL; ++kk)
        for (int src = 0; src < 64; ++src) { const float pj = __shfl(sc[kk], src); const int kidx = src + 64 * kk; int ktok;
            if (NA) ktok = (rs + (kidx >> 4)) * 64 + cs + (kidx & 15); else ktok = kidx;
            const bf16* vp = NA ? Vn + (size_t)ktok * 1024 + h * 128 : KV + (size_t)ktok * 1024 + 512 + h * 128;
            const unsigned v2 = *(const GAS unsigned*)(vp + 2 * lane); o0 += pj * bflo(v2); o1 += pj * bfhi(v2); }
    const float inv = 1.0f / sum;
    *(GAS unsigned*)(Y + (size_t)token * 2048 + (NA ? h * 128 : 1536 + h * 128) + 2 * lane) = pk2(o0 * inv, o1 * inv);
}
__device__ __forceinline__ void ssm_scan_group(Frame& F, int g) {
    typedef float f32x2 __attribute__((ext_vector_type(2)));
    if (F.tid >= 128) return;
    __builtin_amdgcn_fence(__ATOMIC_ACQUIRE, "agent");
    const int dir = F.tid >> 6, p = F.tid & 63;
    const f32x2 a = ((const GAS f32x2*)(F.ws + WS_A64))[(dir * NGRP + g) * 64 + p];
    const GAS float* Sl = (const GAS float*)(F.ws + WS_SLOC) + (size_t)g * 256 * 256 + dir * 128 + p;
    GAS bf16* Hin = (GAS bf16*)(F.ws + WS_U) + (size_t)g * 256 * UPITCH + 1024 + dir * 128 + p;
    float hr = 0.f, hi = 0.f;
    for (int i0 = 0; i0 < NCHK; i0 += 16) { float sr[16], si[16];
#pragma unroll
        for (int k = 0; k < 16; ++k) { const int n = dir == 0 ? i0 + k : NCHK - 1 - i0 - k; sr[k] = Sl[(size_t)n * 256]; si[k] = Sl[(size_t)n * 256 + 64]; }
#pragma unroll
        for (int k = 0; k < 16; ++k) { const int n = dir == 0 ? i0 + k : NCHK - 1 - i0 - k;
            Hin[(size_t)n * UPITCH] = (bf16)f2bf(hr); Hin[(size_t)n * UPITCH + 64] = (bf16)f2bf(hi);
            const float nr = a.x * hr - a.y * hi + sr[k], ni = a.x * hi + a.y * hr + si[k]; hr = nr; hi = ni; } }
}
__device__ __forceinline__ void ynorm_row(int lane, bf16* yrow) {
    GAS v4u* yr = (GAS v4u*)yrow + lane;
    v4u v[4]; float ss[4];
#pragma unroll
    for (int k = 0; k < 4; ++k) { v[k] = yr[64 * k]; float s = 0.f;
#pragma unroll
        for (int j = 0; j < 4; ++j) { const float a = bflo(v[k][j]), b = bfhi(v[k][j]); s += a * a + b * b; }
        ss[k] = s; }
    const float s_na = 1.f / sqrtf(wave_sum(ss[0] + ss[1]) * (1.f / 1024.f) + EPS), s_ssm = 1.f / sqrtf(wave_sum(ss[2]) * (1.f / 512.f) + EPS), s_mem = 1.f / sqrtf(wave_sum(ss[3]) * (1.f / 512.f) + EPS);
#pragma unroll
    for (int k = 0; k < 4; ++k) { const float sc = k < 2 ? s_na : (k == 2 ? s_ssm : s_mem); v4u o;
#pragma unroll
        for (int j = 0; j < 4; ++j) o[j] = pk2(bflo(v[k][j]) * sc, bfhi(v[k][j]) * sc);
        yr[64 * k] = o; }
}
__device__ __forceinline__ void mid_row(int lane, const float* xrow, const bf16* orow, const float* gpost, bf16* hrow, float* rs1out) {
    const GAS f32x4* xr = (const GAS f32x4*)xrow + lane; const GAS unsigned long long* orr = (const GAS unsigned long long*)orow + lane; const GAS f32x4* gr = (const GAS f32x4*)gpost + lane;
    f32x4 v[8]; float s = 0.f;
#pragma unroll
    for (int j = 0; j < 8; ++j) { const unsigned long long w = orr[64 * j]; v[j] = (f32x4){bflo((unsigned)w), bfhi((unsigned)w), bflo((unsigned)(w >> 32)), bfhi((unsigned)(w >> 32))};
        s += (v[j].x * v[j].x + v[j].y * v[j].y) + (v[j].z * v[j].z + v[j].w * v[j].w); }
    const float rs = 1.f / sqrtf(wave_sum(s) * (1.f / DM) + EPS); float s2 = 0.f;
    if (lane == 0) __hip_atomic_store(rs1out, rs, RLX_AGENT);
#pragma unroll
    for (int j = 0; j < 8; ++j) { v[j] = xr[64 * j] + v[j] * rs * gr[64 * j]; s2 += (v[j].x * v[j].x + v[j].y * v[j].y) + (v[j].z * v[j].z + v[j].w * v[j].w); }
    const float rs2 = 1.f / sqrtf(wave_sum(s2) * (1.f / DM) + EPS);
    unsigned long long* o8 = (unsigned long long*)hrow + lane;
#pragma unroll
    for (int j = 0; j < 8; ++j) __hip_atomic_store(o8 + 64 * j, (unsigned long long)pk2(v[j].x * rs2, v[j].y * rs2) | ((unsigned long long)pk2(v[j].z * rs2, v[j].w * rs2) << 32), RLX_AGENT);
}
__device__ __forceinline__ void final_row(int lane, const float* xrow, const bf16* orow, const bf16* frow, float rs1, const float* gpost, const float* gmlp, float* outrow) {
    const GAS f32x4* xr = (const GAS f32x4*)xrow + lane; const GAS unsigned long long* orr = (const GAS unsigned long long*)orow + lane; const GAS unsigned long long* frr = (const GAS unsigned long long*)frow + lane;
    const GAS f32x4* g1 = (const GAS f32x4*)gpost + lane; const GAS f32x4* g2 = (const GAS f32x4*)gmlp + lane; GAS f32x4* outr = (GAS f32x4*)outrow + lane;
    f32x4 fv[8]; float s = 0.f;
#pragma unroll
    for (int j = 0; j < 8; ++j) { const unsigned long long w = frr[64 * j]; fv[j] = (f32x4){bflo((unsigned)w), bfhi((unsigned)w), bflo((unsigned)(w >> 32)), bfhi((unsigned)(w >> 32))};
        s += (fv[j].x * fv[j].x + fv[j].y * fv[j].y) + (fv[j].z * fv[j].z + fv[j].w * fv[j].w); }
    const float rsf = 1.f / sqrtf(wave_sum(s) * (1.f / DM) + EPS);
#pragma unroll
    for (int j = 0; j < 8; ++j) { const unsigned long long w = orr[64 * j]; const f32x4 ov = (f32x4){bflo((unsigned)w), bfhi((unsigned)w), bflo((unsigned)(w >> 32)), bfhi((unsigned)(w >> 32))};
        outr[64 * j] = xr[64 * j] + ov * rs1 * g1[64 * j] + fv[j] * rsf * g2[64 * j]; }
}
__device__ __forceinline__ void bg_transpose(Frame& F, const float* W, int K, int N, bf16* WT, const float* gain, int part, int nparts) {
    LAS float* scr = (LAS float*)(F.lds + RING_OFF + F.wave * 16384);
    const int nitems = (K / 64) * (N / 32), per = (nitems + nparts - 1) / nparts, lo = part * per, hi = min(lo + per, nitems);
    for (int it = lo + F.wave; it < hi; it += NWAVES) p0_transpose_item(W, K, N, WT, gain, scr, it, F.lane);
}

__device__ __forceinline__ void glu_norm_unit(Frame& F, int rb) {
    int tid_ = threadIdx.x; asm volatile("" : "+v"(tid_));
    const int tid = tid_, lane = tid & 63, w = __builtin_amdgcn_readfirstlane(tid >> 6), fr = lane & 15, fq = lane >> 4;
    const bf16* Yg = (const bf16*)(F.ws + WS_YG) + (size_t)rb * 64 * 512; const bf16* WT = (const bf16*)(F.ws + WS_WGLU); bf16* Y = (bf16*)(F.ws + WS_Y) + (size_t)rb * 64 * 2048;
    LAS unsigned char* At = F.lds; LAS float* part = (LAS float*)(F.lds + 65536);
#pragma unroll
    for (int i = 0; i < 8; ++i) { const int idx = tid + 512 * i, row = idx >> 6, ch = idx & 63;
        const v4u v = *(const GAS v4u*)(Yg + (size_t)row * 512 + ch * 8); *(LAS v4u*)(At + row * 1024 + ((ch ^ (row & 15)) << 4)) = v; }
    __syncthreads();
    if (tid < 64) { const size_t row = (size_t)rb * 64 + tid; const GAS f32x4* pn = (const GAS f32x4*)((const float*)(F.ws + WS_SSQ) + row * 8); const f32x4 a = pn[0], b = pn[1];
        const f32x4 c = *(const GAS f32x4*)((const float*)(F.ws + WS_SSQ) + (size_t)SEQ * 8 + row * 4);
        const float s_na = 1.f / sqrtf((((a.x + a.y) + (a.z + a.w)) + ((b.x + b.y) + (b.z + b.w))) * (1.f / 1024.f) + EPS), s_mem = 1.f / sqrtf(((c.x + c.y) + (c.z + c.w)) * (1.f / 512.f) + EPS);
        typedef float f32x2 __attribute__((ext_vector_type(2)));
        __hip_atomic_store((unsigned long long*)(F.ws + WS_RT) + row, (unsigned long long)__float_as_uint(s_na / s_mem) | ((unsigned long long)__float_as_uint(s_mem) << 32), RLX_AGENT); }
    f32x4 acc[4][4];
#pragma unroll
    for (int m = 0; m < 4; ++m)
#pragma unroll
        for (int n = 0; n < 4; ++n) acc[m][n] = (f32x4){0.f, 0.f, 0.f, 0.f};
    const bf16* Bw = WT + (size_t)(64 * w + fr) * 512 + 8 * fq;
    bf16x8 bq0[4], bq1[4];
#pragma unroll
    for (int n = 0; n < 4; ++n) { bq0[n] = *(const GAS bf16x8*)(Bw + (size_t)n * 16 * 512); bq1[n] = *(const GAS bf16x8*)(Bw + (size_t)n * 16 * 512 + 32); }
#pragma unroll 1
    for (int kp = 0; kp < 8; ++kp) { bf16x8 a[4], b[4];
        { const int kc = kp * 8 + fq, kn = min(2 * kp + 2, 15);
#pragma unroll
          for (int n = 0; n < 4; ++n) { b[n] = bq0[n]; bq0[n] = *(const GAS bf16x8*)(Bw + (size_t)n * 16 * 512 + kn * 32); }
#pragma unroll
          for (int m = 0; m < 4; ++m) a[m] = *(const LAS bf16x8*)(At + (m * 16 + fr) * 1024 + ((kc ^ fr) << 4));
#pragma unroll
          for (int m = 0; m < 4; ++m)
#pragma unroll
              for (int n = 0; n < 4; ++n) acc[m][n] = __builtin_amdgcn_mfma_f32_16x16x32_bf16(b[n], a[m], acc[m][n], 0, 0, 0); }
        { const int kc = kp * 8 + 4 + fq, kn = min(2 * kp + 3, 15);
#pragma unroll
          for (int n = 0; n < 4; ++n) { b[n] = bq1[n]; bq1[n] = *(const GAS bf16x8*)(Bw + (size_t)n * 16 * 512 + kn * 32); }
#pragma unroll
          for (int m = 0; m < 4; ++m) a[m] = *(const LAS bf16x8*)(At + (m * 16 + fr) * 1024 + ((kc ^ fr) << 4));
#pragma unroll
          for (int m = 0; m < 4; ++m)
#pragma unroll
              for (int n = 0; n < 4; ++n) acc[m][n] = __builtin_amdgcn_mfma_f32_16x16x32_bf16(b[n], a[m], acc[m][n], 0, 0, 0); } }
    float ss[4];
#pragma unroll
    for (int m = 0; m < 4; ++m) { const int row = m * 16 + fr; float s = 0.f;
#pragma unroll
        for (int n = 0; n < 4; ++n) { const int col = 64 * w + n * 16 + 4 * fq; const f32x4 bb = *(const GAS f32x4*)(F.in[14] + col);
            const unsigned long long yy = *(const LAS unsigned long long*)(At + row * 1024 + (((col >> 3) ^ fr) << 4) + (col & 7) * 2);
            const float y0 = bflo((unsigned)yy), y1 = bfhi((unsigned)yy), y2 = bflo((unsigned)(yy >> 32)), y3 = bfhi((unsigned)(yy >> 32));
            f32x4 v = acc[m][n] + bb;
            v.x = y0 * __builtin_amdgcn_rcpf(1.0f + __builtin_amdgcn_exp2f(-1.4426950408889634f * v.x)); v.y = y1 * __builtin_amdgcn_rcpf(1.0f + __builtin_amdgcn_exp2f(-1.4426950408889634f * v.y));
            v.z = y2 * __builtin_amdgcn_rcpf(1.0f + __builtin_amdgcn_exp2f(-1.4426950408889634f * v.z)); v.w = y3 * __builtin_amdgcn_rcpf(1.0f + __builtin_amdgcn_exp2f(-1.4426950408889634f * v.w));
            acc[m][n] = v; s += (v.x * v.x + v.y * v.y) + (v.z * v.z + v.w * v.w); }
        s += __shfl_xor(s, 16); s += __shfl_xor(s, 32); ss[m] = s;
        if (fq == 0) part[row * 8 + w] = s; }
    __syncthreads();
#pragma unroll
    for (int m = 0; m < 4; ++m) { const int row = m * 16 + fr; const LAS f32x4* pp = (const LAS f32x4*)(part + row * 8); const f32x4 p0 = pp[0], p1 = pp[1];
        const float tot = ((p0.x + p0.y) + (p0.z + p0.w)) + ((p1.x + p1.y) + (p1.z + p1.w)); const float rs = 1.f / sqrtf(tot * (1.f / 512.f) + EPS);
#pragma unroll
        for (int n = 0; n < 4; ++n) { const int col = 64 * w + n * 16 + 4 * fq; const f32x4 v = acc[m][n] * rs;
            __hip_atomic_store((unsigned long long*)(Y + (size_t)row * 2048 + 1536 + col), (unsigned long long)pk2(v.x, v.y) | ((unsigned long long)pk2(v.z, v.w) << 32), RLX_AGENT); } }
    __syncthreads();
}

struct Args { const float* in[26]; float* out; unsigned char* ws; int ph_lo, ph_hi; };
constexpr int N_PHASES = 4;
__global__ void __launch_bounds__(NWAVES * 64, 2) mega(Args args) {
    extern __shared__ __attribute__((aligned(16))) unsigned char lds[];
    Frame F;
    F.lds = (LAS unsigned char*)lds;
    F.MISC = (volatile LAS unsigned*)(F.lds + MISC_OFF);
    F.tid = threadIdx.x; F.lane = F.tid & 63; F.wave = __builtin_amdgcn_readfirstlane(F.tid >> 6);
    F.G = gridDim.x; { const int bx = blockIdx.x; F.vcu = (F.G % 8 == 0) ? (bx % 8) * (F.G / 8) + bx / 8 : bx; }
    F.in = args.in;
    F.out = args.out; F.ws = args.ws; F.ctl = (gu32*)(args.ws + WS_CTL);
    for (int u = F.tid; u < (LDS_BYTES - LDSCTL_OFF) / 4; u += NWAVES * 64) ((LAS unsigned*)(F.lds + LDSCTL_OFF))[u] = 0u;
    __syncthreads();
    XcdBarrier bar = xcd_barrier_post((unsigned*)(F.ctl + CW_BAR), F.MISC + 8);
    const int lo = args.ph_lo, hi = args.ph_hi;
#define IN(k) (lo <= (k) && (k) < hi)
#define SEAM(k) do { if (IN(k) && IN((k) + 1)) xcd_barrier(bar); } while (0)
    unsigned char* ws = F.ws;
    const int gw = F.vcu * NWAVES + F.wave, NGW = F.G * NWAVES;
    using namespace pg8;
    for (int xb = 0; xb < PROBE_XBAR; ++xb) xcd_barrier(bar);
    if (IN(0)) { p0_prologue(F, 0); } SEAM(0);
    if (IN(1)) {
        Gemm g{(const bf16_t*)(ws + WS_XN), (const bf16_t*)(ws + WS_WIN), DM, DM, DM, 0}; StaticOrder S; S.init(SEQ, INW, F.G, (int)blockIdx.x);
        EpiInProj E{ws, WS_QN, WS_U, WS_QM};
        gemm_phase<EpiInProj, StaticOrder, true, true>(F.lds + RING_OFF, g, S, E);
    } SEAM(1);
    if (IN(2)) {
        if (blockIdx.x < NGRP) {
            Gemm g{(const bf16_t*)(ws + WS_U), (const bf16_t*)(ws + WS_PM), 1024, UPITCH, 1024, 0}; OneUnit S; S.u = Unit{(int)blockIdx.x, (int)blockIdx.x, (int)blockIdx.x, 0};
            EpiF32 E{(float*)(ws + WS_SLOC), 256};
            gemm_phase<EpiF32, OneUnit, true, true>(F.lds + RING_OFF, g, S, E);
            for (int sr_ = 0; sr_ < PROBE_SCAN_REP; ++sr_) ssm_scan_group(F, blockIdx.x);
            VM_WAIT(); __syncthreads();
            if (F.tid == 0) { __builtin_amdgcn_fence(__ATOMIC_RELEASE, "agent"); VM_WAIT(); __hip_atomic_store(F.ctl + CW_RDY + 64 * blockIdx.x, 1u, RLX_AGENT); }
        }
        for (unsigned tk = wq_issue(F, F.ctl + CW_Q2, 1);;) { const int uu = wq_take(F, tk); if (uu >= 512 * PROBE_NA_REP) break; const int u = uu & 511;
            const int qb = u >> 3, h = u & 7, r0 = qb * 4, kt0 = min(max(r0 - 4, 0), 248), krh = min(max(r0 - 1, 0), 248) + 7; int nt = krh - kt0 + 1; nt += nt & 1;
            tk = att::na_unit((char*)lds, (const bf16*)(ws + WS_QN) + (size_t)qb * 256 * 1024 + h * 128, (const bf16*)(ws + WS_KN) + h * 128, (const bf16*)(ws + WS_VN) + h * 128,
                         (bf16*)(ws + WS_Y) + (size_t)qb * 256 * 2048 + h * 128, nt, kt0, krh, r0, F.in[4] + h * 465, (float*)(ws + WS_SSQ) + (size_t)qb * 256 * 8 + h, (unsigned*)(F.ctl + CW_Q2)); }
        for (;;) { const int uu = wg_dequeue(F, F.ctl + CW_Q2 + 128, 1); if (uu >= 128) break;
            const int g = uu >> 2, j = uu & 3;
            if (F.tid == 0) { unsigned sp = 0; while (__hip_atomic_load(F.ctl + CW_RDY + 64 * g, RLX_AGENT) == 0u) { __builtin_amdgcn_s_sleep(8); if (++sp > (1u << 22)) break; }
                __builtin_amdgcn_fence(__ATOMIC_ACQUIRE, "agent"); VM_WAIT(); }
            __syncthreads();
            Gemm gd{(const bf16_t*)(ws + WS_U), (const bf16_t*)(ws + WS_BTD), UPITCH, UPITCH, UPITCH, 0}; OneUnit S; S.u = Unit{g, g * 4 + j, g, j};
            EpiSsmD E{(bf16_t*)(ws + WS_YG)};
            gemm_phase<EpiSsmD, OneUnit, true, true>(F.lds + RING_OFF, gd, S, E); }
        for (unsigned tk = wq_issue(F, F.ctl + CW_Q2 + 64, 1);;) { const int uu = wq_take(F, tk); if (uu >= 256 * PROBE_MEM_REP) break; const int v = uu & 255, qb = v >> 2, h = v & 3;
            tk = att::attn_unit<false, 512>((char*)lds, (const bf16*)(ws + WS_QM) + (size_t)qb * 256 * 512 + h * 128, (const bf16*)(ws + WS_KVM) + h * 128, (const bf16*)(ws + WS_KVM) + 512 + h * 128,
                                       (bf16*)(ws + WS_Y) + (size_t)qb * 256 * 2048 + 1024 + h * 128, 4, 0, 0, nullptr, (float*)(ws + WS_SSQ) + (size_t)SEQ * 8 + (size_t)qb * 256 * 4 + h, 4, (unsigned*)(F.ctl + CW_Q2 + 64)); }
    } SEAM(2);
    if (IN(3)) {
        const int c = (int)blockIdx.x, gidx = (c & 7) * 4 + (c >> 6), mem = (c >> 3) & 7, PA = 2 * gidx;
        gu32* gcnt = F.ctl + CW_GRP + 64 * gidx;
        glu_norm_unit(F, 8 * gidx + mem);
        grp_sync(F, gcnt, 8u);
        { Gemm g{(const bf16_t*)(ws + WS_Y), (const bf16_t*)(ws + WS_WOUT), DM, DM, DM, 0}; TwoUnits S; S.u0 = Unit{PA, mem, PA, mem}; S.u1 = Unit{PA + 1, mem, PA + 1, mem};
          EpiOutProj E{(bf16_t*)(ws + WS_XN), DM, (const float*)(ws + WS_RT)};
          gemm_phase<EpiOutProj, TwoUnits, true, true>(F.lds + RING_OFF, g, S, E); }
        grp_sync(F, gcnt, 16u);
        for (int i = 0; i < 8; ++i) { const int m = PA * 256 + 64 * mem + 8 * F.wave + i;
            mid_row(F.lane, F.in[0] + (size_t)m * DM, (const bf16*)(ws + WS_XN) + (size_t)m * DM, F.in[21], (bf16*)(ws + WS_Y) + (size_t)m * DM, (float*)(ws + WS_RS1) + m); }
        grp_sync(F, gcnt, 24u);
        { Gemm g{(const bf16_t*)(ws + WS_Y), (const bf16_t*)(ws + WS_WFF1), DM, DM, DM, 0}; GroupFf1Order S{PA, mem, 0, 8};
          EpiHidden E{ws + WS_HID};
          gemm_phase<EpiHidden, GroupFf1Order, true, true>(F.lds + RING_OFF, g, S, E); }
        grp_sync(F, gcnt, 32u);
#pragma unroll 1
        for (int i = 0; i < 2; ++i) {
            Gemm g{(const bf16_t*)(ws + WS_HID), (const bf16_t*)(ws + WS_W2T), DFF, DFF, DFF, 1}; OneUnit S; S.u = Unit{PA + i, mem, PA + i, mem};
            EpiFusedFinal E{F.in[0], (const bf16_t*)(ws + WS_XN), (const float*)(ws + WS_RS1), F.in[21], F.in[25], F.out, (unsigned*)(ws + WS_XS), (unsigned*)(F.ctl + CW_PAN)};
            gemm_phase<EpiFusedFinal, OneUnit, false, true>(F.lds + RING_OFF, g, S, E); }
    }
#undef IN
#undef SEAM
}

#ifndef PROBE_PREFIX
#define PROBE_PREFIX -1
#endif
#ifndef MK_N_LAUNCHES
#define MK_N_LAUNCHES 1
#endif
extern "C" void kernel_launch(void* const* d_in, const int* in_sizes, int n_in, void* d_out, int out_size, void* d_ws, size_t ws_size, hipStream_t stream) {
    static int grid = 0;
    if (grid == 0) {
        if (n_in != 26 || in_sizes[0] != SEQ * DM || out_size != SEQ * DM || ws_size < WS_END) { fprintf(stderr, "kernel_launch: unexpected shapes: n_in %d in0 %d out %d ws %zu\n", n_in, n_in > 0 ? in_sizes[0] : -1, out_size, ws_size); grid = -1; return; }
        int dev = 0, cus = 0;
        if (hipGetDevice(&dev) != hipSuccess || hipDeviceGetAttribute(&cus, hipDeviceAttributeMultiprocessorCount, dev) != hipSuccess) { grid = -1; return; }
        if (hipFuncSetAttribute((const void*)mega, hipFuncAttributeMaxDynamicSharedMemorySize, LDS_BYTES) != hipSuccess) { fprintf(stderr, "kernel_launch: hipFuncSetAttribute failed\n"); grid = -1; return; }
        grid = cus;
    }
    if (grid < 0) return;
    if (hipMemsetAsync((char*)d_ws + WS_CTL, 0, CTL_ZERO_BYTES, stream) != hipSuccess) return;
    Args a{};
    for (int i = 0; i < 26; ++i) a.in[i] = (const float*)d_in[i];
    a.out = (float*)d_out; a.ws = (unsigned char*)d_ws;
    if (PROBE_PREFIX >= 0) { a.ph_lo = 0; a.ph_hi = PROBE_PREFIX + 1; hipLaunchKernelGGL(mega, dim3(grid), dim3(NWAVES * 64), LDS_BYTES, stream, a); (void)hipMemsetAsync((char*)d_ws + WS_CTL, 0, CTL_ZERO_BYTES, stream); }
    if (MK_N_LAUNCHES == 1) { a.ph_lo = 0; a.ph_hi = N_PHASES; hipLaunchKernelGGL(mega, dim3(grid), dim3(NWAVES * 64), LDS_BYTES, stream, a); }
    else for (int p = 0; p < N_PHASES; ++p) { a.ph_lo = p; a.ph_hi = p + 1; hipLaunchKernelGGL(mega, dim3(grid), dim3(NWAVES * 64), LDS_BYTES, stream, a); }
}
```
